# Optimizing an MI355X kernel written in HIP

```python
import numpy as np
import jax
import jax.numpy as jnp
from jax import lax

D_MODEL = 2048
BATCH = 4
SEQ = 4096
DEPTH = 2

HEAD_DIM = 128
NSA_HEADS = 8
NSA_GROUPS = 2
NSA_HPG = NSA_HEADS // NSA_GROUPS
NSA_WIDTH = NSA_HEADS * HEAD_DIM
NSA_KV_WIDTH = NSA_GROUPS * HEAD_DIM
CMP_BLOCK = 32
CMP_STRIDE = 16
SEL_BLOCK = 64
SEL_TOPN = 16
WINDOW = 512
WIN_Q_BLOCK = 128
SEL_Q_CHUNK = 64
ROPE_DIM = HEAD_DIM // 4
ROPE_THETA = 500000.0
SEL_FORCE = 1.0e6
NEG = -1.0e30
MLSTM_HEADS = 4
MLSTM_DIM = 256
MLSTM_WIDTH = MLSTM_HEADS * MLSTM_DIM
MLSTM_CHUNK = 64
CONV_WIDTH = 4
RET_HEADS = 8
RET_QK_DIM = 256
RET_V_DIM = 512
RET_QK_WIDTH = RET_HEADS * RET_QK_DIM
RET_V_WIDTH = RET_HEADS * RET_V_DIM
RET_CHUNK = 64
RET_ROPE_THETA = 10000.0
FFN_DIM = 5632
N_EXPERTS = 8
TOP_K = 2
MOE_BLOCK = 256
RMS_EPS = 1e-6
POS_OFFSET_RANGE = 1024

EVEN_SPLITS = (NSA_WIDTH, NSA_KV_WIDTH, NSA_KV_WIDTH, NSA_KV_WIDTH, NSA_KV_WIDTH, NSA_KV_WIDTH, NSA_KV_WIDTH, NSA_HEADS * 3, MLSTM_WIDTH, MLSTM_WIDTH, MLSTM_WIDTH, MLSTM_HEADS, MLSTM_HEADS, MLSTM_WIDTH)
EVEN_IN = sum(EVEN_SPLITS)
ODD_SPLITS = (RET_QK_WIDTH, RET_QK_WIDTH, RET_V_WIDTH, RET_V_WIDTH)
ODD_IN = sum(ODD_SPLITS)
N_EVEN = (DEPTH + 1) // 2
N_ODD = DEPTH // 2

kernel_name = 'hybrid_nsa_mlstm_retention_moe'


def _split(y, sizes):
    return jnp.split(y, np.cumsum(sizes)[:-1].tolist(), axis=-1)


def _heads(u, n):
    return u.reshape(u.shape[0], u.shape[1], n, -1)


def rmsnorm(x, g):
    xf = x.astype(jnp.float32)
    y = xf * lax.rsqrt(jnp.mean(xf * xf, axis=-1, keepdims=True) + RMS_EPS)
    return (y * g.astype(jnp.float32)).astype(x.dtype)


def rope(x, pos, rot_dim, theta):
    half = rot_dim // 2
    inv = jnp.power(jnp.float32(theta), -jnp.arange(half, dtype=jnp.float32) * (2.0 / rot_dim))
    ang = pos.astype(jnp.float32)[..., None] * inv
    cos = jnp.cos(ang)[:, :, None, :]
    sin = jnp.sin(ang)[:, :, None, :]
    xf = x.astype(jnp.float32)
    x1, x2 = xf[..., :half], xf[..., half:rot_dim]
    out = jnp.concatenate([x1 * cos - x2 * sin, x1 * sin + x2 * cos, xf[..., rot_dim:]], axis=-1)
    return out.astype(x.dtype)


def _to_chunks(u, size):
    b, s, h = u.shape[:3]
    u = u.astype(jnp.float32).reshape((b, s // size, size, h) + u.shape[3:])
    return jnp.moveaxis(u, (1, 3), (0, 2))


def _from_chunks(u):
    u = jnp.moveaxis(u, (0, 2), (1, 3))
    return u.reshape((u.shape[0], u.shape[1] * u.shape[2]) + u.shape[3:])


def causal_conv_silu(u, w):
    width = w.shape[0]
    s = u.shape[1]
    up = jnp.pad(u, ((0, 0), (width - 1, 0), (0, 0)))
    y = sum(up[:, i:i + s] * w[i] for i in range(width))
    return jax.nn.silu(y)


def swiglu(h, wg, wu, wd):
    return (jax.nn.silu(h @ wg) * (h @ wu)) @ wd


def nsa_attention(q, k_cmp, v_cmp, k_sel, v_sel, k_win, v_win, gate_pre, pos, w_cmp_k, w_cmp_v, pe_cmp, q_gain, k_gain):
    f32 = jnp.float32
    b, s = q.shape[:2]
    g, p, d = NSA_GROUPS, NSA_HPG, HEAD_DIM
    scale = d ** -0.5
    t = jnp.arange(s)
    q = rope(rmsnorm(q, q_gain), pos, ROPE_DIM, ROPE_THETA).reshape(b, s, g, p, d)

    nc = s // CMP_STRIDE - 1
    def compress(tok, w):
        halves = tok.reshape(b, s // CMP_STRIDE, CMP_STRIDE, g, d)
        blk = jnp.concatenate([halves[:, :-1], halves[:, 1:]], axis=2)
        blk = blk + pe_cmp[None, None, :, None, :].astype(blk.dtype)
        return jnp.einsum('bclgd,lde->bcge', blk, w.reshape(CMP_BLOCK, d, d))
    cmp_pos = pos[:, CMP_BLOCK - 1::CMP_STRIDE][:, :nc]
    kc = rope(rmsnorm(compress(k_cmp, w_cmp_k), k_gain), cmp_pos, ROPE_DIM, ROPE_THETA)
    vc = compress(v_cmp, w_cmp_v).astype(f32)
    cmp_end = jnp.arange(nc) * CMP_STRIDE + CMP_BLOCK - 1
    cmask = cmp_end[None, :] <= t[:, None]
    s_c = jnp.einsum('bsgpd,bcgd->bgpsc', q, kc).astype(f32) * scale
    p_c = jax.nn.softmax(jnp.where(cmask, s_c, NEG), axis=-1) * cmask
    o_cmp = jnp.einsum('bgpsc,bcgd->bsgpd', p_c, vc)

    ns = s // SEL_BLOCK
    c_start = np.arange(nc) * CMP_STRIDE
    j_start = np.arange(ns) * SEL_BLOCK
    overlap = jnp.asarray(((c_start[:, None] < j_start[None, :] + SEL_BLOCK) & (c_start[:, None] + CMP_BLOCK > j_start[None, :])).astype(np.float32))
    imp = jnp.einsum('bgpsc,cj->bgsj', p_c, overlap)
    jb = jnp.arange(ns)[None, :]
    cur = (t // SEL_BLOCK)[:, None]
    forced = (jb == 0) | (jb == cur) | (jb == cur - 1)
    imp = jnp.where(jb <= cur, jnp.where(forced, SEL_FORCE, imp), NEG)
    n_top = min(SEL_TOPN, ns)
    _, sel = lax.top_k(imp, n_top)

    ksb = rope(rmsnorm(k_sel, k_gain), pos, ROPE_DIM, ROPE_THETA).reshape(b, ns, SEL_BLOCK, g, d).transpose(0, 3, 1, 2, 4)
    vsb = v_sel.reshape(b, ns, SEL_BLOCK, g, d).transpose(0, 3, 1, 2, 4)
    nq = s // SEL_Q_CHUNK
    q_ch = q.reshape(b, nq, SEL_Q_CHUNK, g, p, d).transpose(1, 0, 3, 4, 2, 5)
    sel_ch = sel.reshape(b, g, nq, SEL_Q_CHUNK, n_top).transpose(2, 0, 1, 3, 4)
    t_ch = t.reshape(nq, SEL_Q_CHUNK)
    bi = jnp.arange(b)[:, None, None, None]
    gi = jnp.arange(g)[None, :, None, None]
    koff = jnp.arange(SEL_BLOCK)
    def sel_chunk(args):
        qc, idx, tq = args
        kg = ksb[bi, gi, idx]
        vg = vsb[bi, gi, idx]
        sc = jnp.einsum('bgpqd,bgqnkd->bgpqnk', qc, kg).astype(f32) * scale
        kpos = idx[..., None] * SEL_BLOCK + koff
        m = (kpos <= tq[None, None, :, None, None])[:, :, None]
        sc = jnp.where(m, sc, NEG).reshape(b, g, p, SEL_Q_CHUNK, n_top * SEL_BLOCK)
        pr = jax.nn.softmax(sc, axis=-1).reshape(b, g, p, SEL_Q_CHUNK, n_top, SEL_BLOCK)
        return jnp.einsum('bgpqnk,bgqnkd->bgpqd', pr, vg.astype(f32))
    o_sel = lax.map(sel_chunk, (q_ch, sel_ch, t_ch))
    o_sel = o_sel.transpose(1, 0, 4, 2, 3, 5).reshape(b, s, g, p, d)

    kwt = rope(rmsnorm(k_win, k_gain), pos, ROPE_DIM, ROPE_THETA)
    nb = s // WIN_Q_BLOCK
    nprev = WINDOW // WIN_Q_BLOCK
    def band(u):
        up = jnp.pad(u, ((0, 0), (WINDOW, 0), (0, 0), (0, 0))).reshape(b, nb + nprev, WIN_Q_BLOCK, g, d)
        return jnp.concatenate([up[:, i:i + nb] for i in range(nprev + 1)], axis=2)
    kb, vb = band(kwt), band(v_win)
    qb = q.reshape(b, nb, WIN_Q_BLOCK, g, p, d)
    s_w = jnp.einsum('bnqgpd,bnkgd->bngpqk', qb, kb).astype(f32) * scale
    blk0 = jnp.arange(nb)[:, None] * WIN_Q_BLOCK
    qpos = blk0 + jnp.arange(WIN_Q_BLOCK)
    kpos = blk0 - WINDOW + jnp.arange(WINDOW + WIN_Q_BLOCK)
    wmask = (kpos[:, None, :] <= qpos[:, :, None]) & (kpos[:, None, :] > qpos[:, :, None] - WINDOW) & (kpos[:, None, :] >= 0)
    p_w = jax.nn.softmax(jnp.where(wmask[None, :, None, None], s_w, NEG), axis=-1)
    o_win = jnp.einsum('bngpqk,bnkgd->bnqgpd', p_w, vb.astype(f32)).reshape(b, s, g, p, d)

    gt = jax.nn.sigmoid(gate_pre.astype(f32)).reshape(b, s, g, p, 3)
    o = gt[..., 0:1] * o_cmp + gt[..., 1:2] * o_sel + gt[..., 2:3] * o_win
    return o.reshape(b, s, NSA_HEADS * d)


def mlstm(q, k, v, i_pre, f_pre, f_bias):
    f32 = jnp.float32
    b, s, nh, dh = q.shape
    L = MLSTM_CHUNK
    qc = _to_chunks(q, L)
    kc = _to_chunks(k, L) * (dh ** -0.5)
    vc = _to_chunks(v, L)
    ic = _to_chunks(i_pre, L)
    lfc = jax.nn.log_sigmoid(_to_chunks(f_pre, L) + f_bias.astype(f32)[:, None])
    causal = jnp.tril(jnp.ones((L, L), dtype=bool))
    def step(carry, xs):
        C, n, m = carry
        q_, k_, v_, ig, lf = xs
        a = jnp.cumsum(lf, axis=-1)
        Dlog = jnp.where(causal, a[..., :, None] - a[..., None, :] + ig[..., None, :], NEG)
        inter = a + m[..., None]
        mt = jnp.maximum(inter, Dlog.max(axis=-1))
        W = jnp.exp(Dlog - mt[..., None]) * jnp.einsum('bhtd,bhsd->bhts', q_, k_)
        e = jnp.exp(inter - mt)
        num = e[..., None] * jnp.einsum('bhtd,bhde->bhte', q_, C) + jnp.einsum('bhts,bhse->bhte', W, v_)
        den = e * jnp.einsum('bhtd,bhd->bht', q_, n) + W.sum(axis=-1)
        h = num / jnp.maximum(jnp.abs(den), jnp.exp(-mt))[..., None]
        aL = a[..., -1]
        gs = aL[..., None] - a + ig
        m_new = jnp.maximum(aL + m, gs.max(axis=-1))
        decay = jnp.exp(aL + m - m_new)
        wk = jnp.exp(gs - m_new[..., None])[..., None] * k_
        C = decay[..., None, None] * C + jnp.einsum('bhsd,bhse->bhde', wk, v_)
        n = decay[..., None] * n + wk.sum(axis=-2)
        return (C, n, m_new), h
    init = (jnp.zeros((b, nh, dh, dh), f32), jnp.zeros((b, nh, dh), f32), jnp.zeros((b, nh), f32))
    _, h = lax.scan(step, init, (qc, kc, vc, ic, lfc))
    return _from_chunks(h)


def retention(q, k, v, pos):
    f32 = jnp.float32
    h_, dk = q.shape[2], q.shape[3]
    L = RET_CHUNK
    q = rope(q, pos, dk, RET_ROPE_THETA)
    k = rope(k, pos, dk, RET_ROPE_THETA)
    log_g = jnp.log1p(-jnp.exp2(-5.0 - jnp.arange(h_, dtype=f32)))
    idx = jnp.arange(L, dtype=f32)
    diff = idx[:, None] - idx[None, :]
    Dm = jnp.where(diff >= 0, jnp.exp(jnp.maximum(diff, 0.0) * log_g[:, None, None]), 0.0)
    xi = jnp.exp((idx + 1.0) * log_g[:, None])
    zeta = jnp.exp((L - 1.0 - idx) * log_g[:, None])
    chunk_decay = jnp.exp(L * log_g)
    qc = _to_chunks(q, L)
    kc = _to_chunks(k, L) * (dk ** -0.5)
    vc = _to_chunks(v, L)
    def step(R, xs):
        q_, k_, v_ = xs
        inner = jnp.einsum('bhts,bhse->bhte', jnp.einsum('bhtd,bhsd->bhts', q_, k_) * Dm, v_)
        cross = jnp.einsum('bhtd,bhde->bhte', q_, R) * xi[..., None]
        R = chunk_decay[:, None, None] * R + jnp.einsum('bhsd,bhse->bhde', k_ * zeta[..., None], v_)
        return R, inner + cross
    b = q.shape[0]
    R0 = jnp.zeros((b, h_, dk, v.shape[3]), f32)
    _, o = lax.scan(step, R0, (qc, kc, vc))
    return _from_chunks(o)


def moe_swiglu(x, w_router, w_gate, w_up, w_down):
    f32 = jnp.float32
    b, s, dm = x.shape
    n = b * s
    xt = x.reshape(n, dm)
    logits = (xt @ w_router).astype(f32)
    top_val, top_idx = lax.top_k(logits, TOP_K)
    gate = jax.nn.softmax(top_val, axis=-1)
    flat_e = top_idx.reshape(-1)
    flat_tok = jnp.arange(n * TOP_K, dtype=jnp.int32) // TOP_K
    flat_gate = gate.reshape(-1)
    order = jnp.argsort(flat_e)
    se, stok, sgate = flat_e[order], flat_tok[order], flat_gate[order]
    counts = jnp.bincount(flat_e, length=N_EXPERTS)
    padded = (counts + MOE_BLOCK - 1) // MOE_BLOCK * MOE_BLOCK
    start = jnp.cumsum(counts) - counts
    pend = jnp.cumsum(padded)
    pstart = pend - padded
    dest = pstart[se] + jnp.arange(n * TOP_K, dtype=jnp.int32) - start[se]
    n_blk = -(-(n * TOP_K) // MOE_BLOCK) + N_EXPERTS
    n_rows = n_blk * MOE_BLOCK
    row_tok = jnp.full((n_rows,), n, dtype=jnp.int32).at[dest].set(stok)
    x_ext = jnp.concatenate([xt, jnp.zeros((1, dm), xt.dtype)], axis=0)
    xb = x_ext[row_tok].reshape(n_blk, MOE_BLOCK, dm)
    blk_e = jnp.minimum(jnp.searchsorted(pend, jnp.arange(n_blk) * MOE_BLOCK, side='right'), N_EXPERTS - 1)
    def expert_block(args):
        xb_, e = args
        return (jax.nn.silu(xb_ @ w_gate[e]) * (xb_ @ w_up[e])) @ w_down[e]
    yb = lax.map(expert_block, (xb, blk_e)).reshape(n_rows, dm)
    y = jnp.zeros((n, dm), f32).at[stok].add(yb[dest].astype(f32) * sgate[:, None])
    return y.astype(x.dtype).reshape(b, s, dm)


def setup_inputs(seed: int = 0) -> dict:
    key = jax.random.key(seed)
    keys = iter(jax.random.split(key, 40))
    f32 = jnp.float32
    def dense(shape, fan_in):
        return jax.random.normal(next(keys), shape, f32) * (fan_in ** -0.5)
    def gain(shape):
        return 1.0 + 0.02 * jax.random.normal(next(keys), shape, f32)
    def small(shape, scale):
        return scale * jax.random.normal(next(keys), shape, f32)
    ne, no = N_EVEN, N_ODD
    x = jax.random.normal(next(keys), (BATCH, SEQ, D_MODEL), f32)
    offset = jax.random.randint(next(keys), (BATCH, 1), 0, POS_OFFSET_RANGE, dtype=jnp.int32)
    positions = offset + jnp.arange(SEQ, dtype=jnp.int32)[None, :]
    return {
        'x': x,
        'positions': positions,
        'norm_mix_even': gain((ne, D_MODEL)),
        'w_in_even': dense((ne, D_MODEL, EVEN_IN), D_MODEL),
        'nsa_q_gain': gain((ne, HEAD_DIM)),
        'nsa_k_gain': gain((ne, HEAD_DIM)),
        'w_cmp_k': dense((ne, CMP_BLOCK * HEAD_DIM, HEAD_DIM), CMP_BLOCK * HEAD_DIM),
        'w_cmp_v': dense((ne, CMP_BLOCK * HEAD_DIM, HEAD_DIM), CMP_BLOCK * HEAD_DIM),
        'pe_cmp': small((ne, CMP_BLOCK, HEAD_DIM), 0.1),
        'mlstm_conv': dense((ne, CONV_WIDTH, 2 * MLSTM_WIDTH), CONV_WIDTH),
        'mlstm_f_bias': jnp.linspace(3.0, 6.0, MLSTM_HEADS, dtype=f32)[None, :] + small((ne, MLSTM_HEADS), 0.1),
        'mlstm_norm': gain((ne, MLSTM_WIDTH)),
        'w_out_even': dense((ne, NSA_WIDTH + MLSTM_WIDTH, D_MODEL), NSA_WIDTH + MLSTM_WIDTH),
        'norm_ffn_even': gain((ne, D_MODEL)),
        'ffn_gate': dense((ne, D_MODEL, FFN_DIM), D_MODEL),
        'ffn_up': dense((ne, D_MODEL, FFN_DIM), D_MODEL),
        'ffn_down': dense((ne, FFN_DIM, D_MODEL), FFN_DIM),
        'norm_mix_odd': gain((no, D_MODEL)),
        'w_in_odd': dense((no, D_MODEL, ODD_IN), D_MODEL),
        'ret_norm': gain((no, RET_V_WIDTH)),
        'w_out_odd': dense((no, RET_V_WIDTH, D_MODEL), RET_V_WIDTH),
        'norm_ffn_odd': gain((no, D_MODEL)),
        'w_router': dense((no, D_MODEL, N_EXPERTS), D_MODEL),
        'exp_gate': dense((no, N_EXPERTS, D_MODEL, FFN_DIM), D_MODEL),
        'exp_up': dense((no, N_EXPERTS, D_MODEL, FFN_DIM), D_MODEL),
        'exp_down': dense((no, N_EXPERTS, FFN_DIM, D_MODEL), FFN_DIM),
    }


def reference(x, positions, norm_mix_even, w_in_even, nsa_q_gain, nsa_k_gain, w_cmp_k, w_cmp_v, pe_cmp, mlstm_conv, mlstm_f_bias, mlstm_norm, w_out_even, norm_ffn_even, ffn_gate, ffn_up, ffn_down, norm_mix_odd, w_in_odd, ret_norm, w_out_odd, norm_ffn_odd, w_router, exp_gate, exp_up, exp_down):
    b, s, _ = x.shape
    for layer in range(DEPTH):
        j = layer // 2
        if layer % 2 == 0:
            h = rmsnorm(x, norm_mix_even[j])
            (q_a, kc_a, vc_a, ks_a, vs_a, kw_a, vw_a, g_a, q_b, k_b, v_b, i_b, f_b, o_b) = _split(h @ w_in_even[j], EVEN_SPLITS)
            o_nsa = nsa_attention(_heads(q_a, NSA_HEADS), _heads(kc_a, NSA_GROUPS), _heads(vc_a, NSA_GROUPS), _heads(ks_a, NSA_GROUPS), _heads(vs_a, NSA_GROUPS), _heads(kw_a, NSA_GROUPS), _heads(vw_a, NSA_GROUPS), _heads(g_a, NSA_HEADS), positions, w_cmp_k[j], w_cmp_v[j], pe_cmp[j], nsa_q_gain[j], nsa_k_gain[j])
            qk_b = causal_conv_silu(jnp.concatenate([q_b, k_b], axis=-1), mlstm_conv[j])
            h_b = mlstm(_heads(qk_b[..., :MLSTM_WIDTH], MLSTM_HEADS), _heads(qk_b[..., MLSTM_WIDTH:], MLSTM_HEADS), _heads(v_b, MLSTM_HEADS), i_b, f_b, mlstm_f_bias[j])
            h_b = rmsnorm(h_b, mlstm_norm[j].reshape(MLSTM_HEADS, MLSTM_DIM)).reshape(b, s, MLSTM_WIDTH) * jax.nn.sigmoid(o_b.astype(jnp.float32))
            mixed = jnp.concatenate([o_nsa, h_b], axis=-1).astype(x.dtype)
            x = x + mixed @ w_out_even[j]
            x = x + swiglu(rmsnorm(x, norm_ffn_even[j]), ffn_gate[j], ffn_up[j], ffn_down[j])
        else:
            h = rmsnorm(x, norm_mix_odd[j])
            q_c, k_c, v_c, g_c = _split(h @ w_in_odd[j], ODD_SPLITS)
            y = retention(_heads(q_c, RET_HEADS), _heads(k_c, RET_HEADS), _heads(v_c, RET_HEADS), positions)
            y = rmsnorm(y, ret_norm[j].reshape(RET_HEADS, RET_V_DIM)).reshape(b, s, RET_V_WIDTH) * jax.nn.silu(g_c.astype(jnp.float32))
            x = x + y.astype(x.dtype) @ w_out_odd[j]
            x = x + moe_swiglu(rmsnorm(x, norm_ffn_odd[j]), w_router[j], exp_gate[j], exp_up[j], exp_down[j])
    return x
```

```cpp
#include <hip/hip_runtime.h>
#include <cstdio>
#include <cstdint>

#define LAS __attribute__((address_space(3)))
typedef unsigned short bf16;
typedef short bf16x8 __attribute__((ext_vector_type(8)));
typedef float f32x4 __attribute__((ext_vector_type(4)));
typedef float f32x2 __attribute__((ext_vector_type(2)));
typedef unsigned u32x4 __attribute__((ext_vector_type(4)));
typedef unsigned u32x2 __attribute__((ext_vector_type(2)));

constexpr int BATCH = 4, SEQ = 4096, DM = 2048, MTOK = BATCH * SEQ;
constexpr int HD = 128, NSA_H = 8, NSA_G = 2, NC = 255, NSB = 64;
constexpr int ML_H = 4, ML_D = 256;
constexpr int RT_H = 8, RT_DK = 256, RT_DV = 512;
constexpr int FFN = 5632, NEXP = 8;
constexpr int EVEN_IN = 6688, ODD_IN = 12288;
constexpr float RMS_EPS = 1e-6f;
constexpr int LDY0 = 6912, YQ = 0, YKC = 1024, YVC = 1280, YKS = 1536, YVS = 1792, YKW = 2048, YVW = 2304, YMQ = 2560, YMK = 3584, YMV = 4608, YMO = 5632, YG = 6656, YI = 6680, YF = 6684;
constexpr int LDY1 = 12288;
constexpr int MOE_ROWS = 2 * MTOK + NEXP * 256;

constexpr size_t MiB = 1u << 20;
constexpr size_t WS_CTL = 0, CTL_ZERO_BYTES = 1 * MiB;
constexpr size_t WS_WIE = 2 * MiB, WS_WOE = 29 * MiB, WS_WGU = 37 * MiB, WS_WD = 81 * MiB, WS_WIO = 103 * MiB, WS_WOO = 151 * MiB, WS_EGU = 167 * MiB, WS_ED = 519 * MiB;
constexpr size_t WS_WCK = 695 * MiB, WS_WCV = 696 * MiB, WS_MISC = 697 * MiB, WS_H = 698 * MiB, WS_XB = 762 * MiB, WS_R = 890 * MiB;
constexpr size_t WS_Y0 = WS_R, WS_ACT = WS_R, WS_QN = WS_R + 216 * MiB, WS_KSN = WS_QN + 32 * MiB, WS_KWN = WS_KSN + 8 * MiB, WS_MQ = WS_KWN + 8 * MiB, WS_MK = WS_MQ + 32 * MiB,
                 WS_KCN = WS_MK + 32 * MiB, WS_VCC = WS_KCN + 1 * MiB, WS_SB = WS_VCC + 1 * MiB, WS_HRAW = WS_SB + 16 * MiB, WS_MIXED = WS_HRAW + 64 * MiB, WS_VST = WS_MIXED + 64 * MiB, WS_VWT = WS_VST + 8 * MiB, WS_VCT = WS_VWT + 8 * MiB, WS_L0END = WS_VCT + 1 * MiB;
constexpr size_t WS_Y1 = WS_R, WS_YRET = WS_R + 384 * MiB, WS_QR = 2 * MiB, WS_SR = 66 * MiB, WS_KR = WS_H;
constexpr size_t WS_XBM = WS_R, WS_ACTE = WS_R + 136 * MiB, WS_YB = 2 * MiB;
constexpr size_t WS_RSS = WS_R + 512 * MiB;
constexpr size_t WS_NEED = WS_RSS + 2 * MiB;
static_assert(WS_L0END <= WS_NEED && WS_ACTE + (size_t)MOE_ROWS * FFN * 2 <= WS_NEED, "ws map");
constexpr size_t MS_TOKE = 0, MS_TOKG = 128 * 1024, MS_TOKD = 256 * 1024, MS_RSTD = 384 * 1024, MS_PEW = 512 * 1024;
constexpr int CW_CNT = 64, CW_CUR = 128, CW_PST = 192, CW_NBLK = 320, CW_BLKE = 384, CW_NSAQ = 1024, CW_BAR = 4096;

__device__ __forceinline__ float bf2f(unsigned b) { return __uint_as_float(b << 16); }
__device__ __forceinline__ unsigned f2bf(float f) { unsigned u = __float_as_uint(f); return (u + 0x7fffu + ((u >> 16) & 1u)) >> 16; }
__device__ __forceinline__ unsigned pk2(float lo, float hi) { return f2bf(lo) | (f2bf(hi) << 16); }
__device__ __forceinline__ unsigned pk4_fp8(float a, float b, float c2, float d) {
    a = fminf(fmaxf(a, -440.f), 440.f); b = fminf(fmaxf(b, -440.f), 440.f); c2 = fminf(fmaxf(c2, -440.f), 440.f); d = fminf(fmaxf(d, -440.f), 440.f);
    int p = __builtin_amdgcn_cvt_pk_fp8_f32(a, b, 0, false); p = __builtin_amdgcn_cvt_pk_fp8_f32(c2, d, p, true); return (unsigned)p; }
__device__ __forceinline__ float lo16(unsigned w) { return __uint_as_float(w << 16); }
__device__ __forceinline__ float hi16(unsigned w) { return __uint_as_float(w & 0xffff0000u); }
__device__ __forceinline__ float wave_sum(float v) {
#pragma unroll
    for (int o = 1; o < 64; o <<= 1) v += __shfl_xor(v, o);
    return v;
}
__device__ __forceinline__ float wave_max(float v) {
#pragma unroll
    for (int o = 1; o < 64; o <<= 1) v = fmaxf(v, __shfl_xor(v, o));
    return v;
}
__device__ __forceinline__ float sigmoidf_(float x) { return 1.f / (1.f + __expf(-x)); }
__device__ __forceinline__ float siluf_(float x) { return x / (1.f + __expf(-x)); }
#define LDS_WAIT() asm volatile("s_waitcnt lgkmcnt(0)" ::: "memory")
#define VM_WAIT() asm volatile("s_waitcnt vmcnt(0)" ::: "memory")
#define LDS_BARRIER() do { asm volatile("s_waitcnt lgkmcnt(0)" ::: "memory"); __builtin_amdgcn_s_barrier(); asm volatile("" ::: "memory"); } while (0)

struct Args { const float* in[26]; float* out; unsigned char* ws; int ph_lo, ph_hi; };
typedef const __attribute__((address_space(4))) Args& KArgs;
__device__ __forceinline__ KArgs get_args() { const __attribute__((address_space(4))) Args* p = (const __attribute__((address_space(4))) Args*)__builtin_amdgcn_kernarg_segment_ptr(); asm volatile("" : "+s"(p)); return *p; }
enum { I_X = 0, I_POS, I_NME, I_WIE, I_QG, I_KG, I_WCK, I_WCV, I_PE, I_CONV, I_FB, I_MNORM, I_WOE, I_NFE, I_FG, I_FU, I_FD, I_NMO, I_WIO, I_RNORM, I_WOO, I_NFO, I_WR, I_EG, I_EU, I_ED };

namespace pg8 {
#define PG8_LAS __attribute__((address_space(3)))
typedef unsigned short bf16_t;
constexpr int BM = 256, BK = 64, HALF = 128, HTB = HALF * BK * 2, STAGE_BYTES = 8 * HTB, NXCD = 8, WGM = 8;
__host__ __device__ __forceinline__ int lds_byte(int r, int c) { const int st = (r >> 4) * 2 + (c >> 5), rr = r & 15, cc = c & 31, ob = rr * 64 + cc * 2; return st * 1024 + (ob ^ (((ob >> 9) & 1) << 5)); }
__host__ __device__ __forceinline__ void stage_rc(int b, int& R, int& C) { const int st = b / 1024, sb = b % 1024, swz = sb ^ (((sb >> 9) & 1) << 5); R = (st >> 1) * 16 + swz / 64; C = (st & 1) * 32 + (swz % 64) / 2; }
__host__ __device__ __forceinline__ int perm32(int rho) { const int n = rho >> 4, i = rho & 15; return 8 * (i >> 2) + 4 * n + (i & 3); }
struct Unit { int pm, pn; };
struct Gemm { const void* A; const void* Bt; int K; const float* rss; };
typedef int v8i32 __attribute__((ext_vector_type(8)));
typedef int v4i32 __attribute__((ext_vector_type(4)));
struct StaticOrder {
    int nM, nN, nwg, G, c;
    __device__ void init(int nM_, int nN_, int G_, int c_) { nM = nM_; nN = nN_; nwg = nM * nN; G = G_; c = c_; }
    __device__ bool next(int i, Unit& u) const {
        const long L = (long)i * G + c; if (L >= nwg) return false;
        int wgid = (int)L; { const int q = nwg / NXCD, r = nwg % NXCD, xcd = wgid % NXCD, off = wgid / NXCD; wgid = (xcd < r ? xcd * (q + 1) : r * (q + 1) + (xcd - r) * q) + off; }
        const int nig = WGM * nN, gid = wgid / nig, fm = gid * WGM, gsz = (nM - fm) < WGM ? (nM - fm) : WGM;
        u.pm = fm + ((wgid % nig) % gsz); u.pn = (wgid % nig) / gsz; return true;
    }
    __device__ __forceinline__ size_t boff(const Unit&) const { return 0; }
};
struct PanelOrder {
    int nN, G, c;
    __device__ void init(int, int nN_, int G_, int c_) { nN = nN_; G = G_; c = c_; }
    __device__ bool next(int i, Unit& u) const {
        if (G != 256) { const long L = (long)i * G + c; if (L >= 64L * nN) return false; u.pm = (int)(L / nN); u.pn = (int)(L % nN); return true; }
        const int xcd = c & 7, idx = c >> 3; u.pm = xcd * 8 + (idx >> 2); u.pn = (idx & 3) + 4 * i; return u.pn < nN;
    }
    __device__ __forceinline__ size_t boff(const Unit&) const { return 0; }
};
struct MoeOrder : StaticOrder {
    int pb[8]; size_t estride;
    __device__ __forceinline__ void load(const unsigned* pbt) {
#pragma unroll
        for (int q = 0; q < 8; ++q) pb[q] = __builtin_amdgcn_readfirstlane((int)__hip_atomic_load(pbt + q, __ATOMIC_RELAXED, __HIP_MEMORY_SCOPE_AGENT)); }
    __device__ __forceinline__ size_t boff(const Unit& u) const { int e = 0;
#pragma unroll
        for (int q = 1; q < 8; ++q) e += (u.pm >= pb[q]) ? 1 : 0;
        return (size_t)e * estride; }
};
__device__ __forceinline__ unsigned cvt_pk_bf16(float lo, float hi) { unsigned r; asm volatile("v_cvt_pk_bf16_f32 %0, %1, %2" : "=v"(r) : "v"(lo), "v"(hi)); return r; }

struct EpiBf16 {
    static constexpr bool PERM = true, ROWSCALE = false;
    bf16_t* O; int ldc; float sc;
    __device__ __forceinline__ void operator()(const f32x4 (&acc)[2][2][4][2], const Unit& u, int wr, int wc, int fr, int fq, const PG8_LAS float*) const {
        const int row0 = u.pm * BM + wr * 64 + fr, col0 = u.pn * BM + wc * 32 + 8 * fq;
#pragma unroll
        for (int ai = 0; ai < 2; ++ai)
#pragma unroll
            for (int m = 0; m < 4; ++m) { bf16_t* rowp = O + (size_t)(row0 + ai * HALF + m * 16) * ldc + col0;
#pragma unroll
                for (int bj = 0; bj < 2; ++bj) { const f32x4 v0 = acc[ai][bj][m][0] * sc, v1 = acc[ai][bj][m][1] * sc;
                    u32x4 w; w.x = cvt_pk_bf16(v0[0], v0[1]); w.y = cvt_pk_bf16(v0[2], v0[3]); w.z = cvt_pk_bf16(v1[0], v1[1]); w.w = cvt_pk_bf16(v1[2], v1[3]);
                    *(u32x4*)(rowp + bj * HALF) = w; } }
    }
};
struct EpiSwigluF8 {
    static constexpr bool PERM = true, ROWSCALE = false;
    unsigned char* O; int ldc; float iscale, oscale;
    __device__ __forceinline__ void operator()(const f32x4 (&acc)[2][2][4][2], const Unit& u, int wr, int wc, int fr, int fq, const PG8_LAS float*) const {
        const int row0 = u.pm * BM + wr * 64 + fr, col0 = u.pn * HALF + wc * 32 + 8 * fq;
        const float k1 = -1.4426950408889634f * iscale, ik2 = 1.f / (iscale * iscale * oscale);
#pragma unroll
        for (int ai = 0; ai < 2; ++ai)
#pragma unroll
            for (int m = 0; m < 4; ++m) { float o[8];
#pragma unroll
                for (int n = 0; n < 2; ++n)
#pragma unroll
                    for (int j = 0; j < 4; ++j) { const float ag = acc[ai][0][m][n][j], au = acc[ai][1][m][n][j], e = __builtin_amdgcn_exp2f(ag * k1); o[n * 4 + j] = (ag * au) * __builtin_amdgcn_rcpf(fmaf(e, ik2, ik2)); }
                u32x2 w; w.x = pk4_fp8(o[0], o[1], o[2], o[3]); w.y = pk4_fp8(o[4], o[5], o[6], o[7]);
                *(u32x2*)(O + (size_t)(row0 + ai * HALF + m * 16) * ldc + col0) = w; }
    }
};
constexpr int RS_LDS_OFF = 131072;
template <bool RSSW> struct EpiResB16 {
    static constexpr bool PERM = true, ROWSCALE = false;
    const bf16_t* base; bf16_t* out; int ldc; float* rss;
    __device__ __forceinline__ void operator()(const f32x4 (&acc)[2][2][4][2], const Unit& u, int wr, int wc, int fr, int fq, const PG8_LAS float*) const {
        const int row0 = u.pm * BM + wr * 64 + fr, col0 = u.pn * BM + wc * 32 + 8 * fq;
#pragma unroll
        for (int ai = 0; ai < 2; ++ai)
#pragma unroll
            for (int m = 0; m < 4; ++m) { const int row = row0 + ai * HALF + m * 16; const size_t off = (size_t)row * ldc + col0; float ss = 0.f;
#pragma unroll
                for (int bj = 0; bj < 2; ++bj) { const u32x4 bs = *(const u32x4*)(base + off + bj * HALF); const f32x4 a0 = acc[ai][bj][m][0], a1 = acc[ai][bj][m][1];
                    const float x0 = lo16(bs.x) + a0[0], x1 = hi16(bs.x) + a0[1], x2 = lo16(bs.y) + a0[2], x3 = hi16(bs.y) + a0[3], x4 = lo16(bs.z) + a1[0], x5 = hi16(bs.z) + a1[1], x6 = lo16(bs.w) + a1[2], x7 = hi16(bs.w) + a1[3];
                    ss += ((x0 * x0 + x1 * x1) + (x2 * x2 + x3 * x3)) + ((x4 * x4 + x5 * x5) + (x6 * x6 + x7 * x7));
                    u32x4 w; w.x = cvt_pk_bf16(x0, x1); w.y = cvt_pk_bf16(x2, x3); w.z = cvt_pk_bf16(x4, x5); w.w = cvt_pk_bf16(x6, x7); *(u32x4*)(out + off + bj * HALF) = w; }
                if (RSSW) { ss += __shfl_xor(ss, 16); ss += __shfl_xor(ss, 32); if (fq == 0) rss[(size_t)row * 32 + u.pn * 4 + wc] = ss; } }
    }
};
struct EpiBf16RS {
    static constexpr bool PERM = true, ROWSCALE = true;
    bf16_t* O; int ldc;
    __device__ __forceinline__ void operator()(const f32x4 (&acc)[2][2][4][2], const Unit& u, int wr, int wc, int fr, int fq, const PG8_LAS float* rs) const {
        const int rl0 = wr * 64 + fr, col0 = u.pn * BM + wc * 32 + 8 * fq;
#pragma unroll
        for (int ai = 0; ai < 2; ++ai)
#pragma unroll
            for (int m = 0; m < 4; ++m) { const int rl = rl0 + ai * HALF + m * 16; const float sc = rs[rl]; bf16_t* rowp = O + (size_t)(u.pm * BM + rl) * ldc + col0;
#pragma unroll
                for (int bj = 0; bj < 2; ++bj) { const f32x4 v0 = acc[ai][bj][m][0] * sc, v1 = acc[ai][bj][m][1] * sc;
                    u32x4 w; w.x = cvt_pk_bf16(v0[0], v0[1]); w.y = cvt_pk_bf16(v0[2], v0[3]); w.z = cvt_pk_bf16(v1[0], v1[1]); w.w = cvt_pk_bf16(v1[2], v1[3]);
                    *(u32x4*)(rowp + bj * HALF) = w; } }
    }
};
struct EpiSwigluRS {
    static constexpr bool PERM = true, ROWSCALE = true;
    bf16_t* O; int ldc;
    __device__ __forceinline__ void operator()(const f32x4 (&acc)[2][2][4][2], const Unit& u, int wr, int wc, int fr, int fq, const PG8_LAS float* rs) const {
        const int rl0 = wr * 64 + fr, col0 = u.pn * HALF + wc * 32 + 8 * fq;
#pragma unroll
        for (int ai = 0; ai < 2; ++ai)
#pragma unroll
            for (int m = 0; m < 4; ++m) { const int rl = rl0 + ai * HALF + m * 16; const float sc = rs[rl]; bf16_t* rowp = O + (size_t)(u.pm * BM + rl) * ldc + col0;
                const float k1 = -1.4426950408889634f * sc, ik2 = __builtin_amdgcn_rcpf(sc * sc);
                float o[8];
#pragma unroll
                for (int n = 0; n < 2; ++n)
#pragma unroll
                    for (int j = 0; j < 4; ++j) { const float ag = acc[ai][0][m][n][j], au = acc[ai][1][m][n][j], e = __builtin_amdgcn_exp2f(ag * k1); o[n * 4 + j] = (ag * au) * __builtin_amdgcn_rcpf(fmaf(e, ik2, ik2)); }
                u32x4 w; w.x = cvt_pk_bf16(o[0], o[1]); w.y = cvt_pk_bf16(o[2], o[3]); w.z = cvt_pk_bf16(o[4], o[5]); w.w = cvt_pk_bf16(o[6], o[7]);
                *(u32x4*)rowp = w; }
    }
};
struct EpiBf16RopeRS {
    static constexpr bool PERM = true, ROWSCALE = true;
    bf16_t* O; int ldc; const int* pos;
    __device__ __forceinline__ void operator()(const f32x4 (&acc)[2][2][4][2], const Unit& u, int wr, int wc, int fr, int fq, const PG8_LAS float* rs) const {
        const int rl0 = wr * 64 + fr, col0 = u.pn * BM + wc * 32 + 8 * fq;
        const bool rot = u.pn < 16; const float ksc = (u.pn >= 8 && u.pn < 16) ? 0.0625f : 1.f;
        float inv[8];
#pragma unroll
        for (int j = 0; j < 8; ++j) inv[j] = __builtin_amdgcn_exp2f(-(float)(wc * 32 + 8 * fq + j) * (13.287712379549449f / 128.f));
#pragma unroll
        for (int ai = 0; ai < 2; ++ai)
#pragma unroll
            for (int m = 0; m < 4; ++m) { const int rl = rl0 + ai * HALF + m * 16, row = u.pm * BM + rl; const float sc = rs[rl] * ksc; bf16_t* rowp = O + (size_t)row * ldc + col0;
                float a1[8], a2[8];
#pragma unroll
                for (int n = 0; n < 2; ++n)
#pragma unroll
                    for (int j = 0; j < 4; ++j) { a1[n * 4 + j] = acc[ai][0][m][n][j] * sc; a2[n * 4 + j] = acc[ai][1][m][n][j] * sc; }
                if (rot) { const float p = (float)pos[row];
#pragma unroll
                    for (int j = 0; j < 8; ++j) { const float an = p * inv[j], sn = __sinf(an), cs = __cosf(an); const float x1 = a1[j], x2 = a2[j]; a1[j] = x1 * cs - x2 * sn; a2[j] = x1 * sn + x2 * cs; } }
                u32x4 w; w.x = cvt_pk_bf16(a1[0], a1[1]); w.y = cvt_pk_bf16(a1[2], a1[3]); w.z = cvt_pk_bf16(a1[4], a1[5]); w.w = cvt_pk_bf16(a1[6], a1[7]); *(u32x4*)rowp = w;
                w.x = cvt_pk_bf16(a2[0], a2[1]); w.y = cvt_pk_bf16(a2[2], a2[3]); w.z = cvt_pk_bf16(a2[4], a2[5]); w.w = cvt_pk_bf16(a2[6], a2[7]); *(u32x4*)(rowp + HALF) = w; }
    }
};

template <bool F8, class Epi, class Sched>
__device__ __forceinline__ void gemm_phase(PG8_LAS unsigned char* lds, const Gemm g, const Sched& S, const Epi& E) {
    int tid_ = threadIdx.x; asm volatile("" : "+v"(tid_));
    const int tid = tid_, wid = __builtin_amdgcn_readfirstlane(tid >> 6), lane = tid & 63, wr = wid >> 2, wc = wid & 3, fr = lane & 15, fq = lane >> 4;
    const int K = g.K, RB = F8 ? K : 2 * K  , nt = RB / 128;
    unsigned voffA[2], voffB[2];
#pragma unroll
    for (int i = 0; i < 2; ++i) { int R, C; stage_rc(tid * 16 + i * 8192, R, C); const int Rb = Epi::PERM ? ((R & ~31) + perm32(R & 31)) : R;
        voffA[i] = (unsigned)(R * RB + 2 * C); voffB[i] = (unsigned)(Rb * RB + 2 * C); }
    const size_t kstep = (size_t)(BK * 2);
    const size_t hstep = (size_t)HALF * RB;
    const size_t tstep = 2 * hstep;
    const unsigned ldsw = (unsigned)wid * 1024u;
    const int aoff = lds_byte(wr * 64 + fr, fq * 8), boff = lds_byte(wc * 32 + fr, fq * 8);
#define PG8_SA(b, h) (((b) * 2 + (h)) * HTB)
#define PG8_SB(b, h) ((4 + (b) * 2 + (h)) * HTB)
#define PG8_STAGE(bufoff, gbase, voff) do { _Pragma("unroll") for (int _i = 0; _i < 2; ++_i) \
        __builtin_amdgcn_global_load_lds((const unsigned*)((const char*)(gbase) + (voff)[_i]), (PG8_LAS unsigned*)(lds + (bufoff) + ldsw + _i * 8192), 16, 0, 0); } while (0)
#define PG8_LD2(p_) __builtin_shufflevector(*(const PG8_LAS v4i32*)(p_), *(const PG8_LAS v4i32*)((p_) + 1024), 0, 1, 2, 3, 4, 5, 6, 7)
#define PG8_LDA(dst, b, h) do { _Pragma("unroll") for (int m = 0; m < 4; ++m) dst[m] = PG8_LD2(lds + PG8_SA(b, h) + aoff + m * 2048); } while (0)
#define PG8_LDB(dst, b, h) do { _Pragma("unroll") for (int n = 0; n < 2; ++n) dst[n] = PG8_LD2(lds + PG8_SB(b, h) + boff + n * 2048); } while (0)
#define PG8_LO(x_) __builtin_bit_cast(bf16x8, __builtin_shufflevector(x_, x_, 0, 1, 2, 3))
#define PG8_HI(x_) __builtin_bit_cast(bf16x8, __builtin_shufflevector(x_, x_, 4, 5, 6, 7))
#define PG8_MMA(ai, bj, At, Bt) do { __builtin_amdgcn_s_setprio(1); _Pragma("unroll") for (int m = 0; m < 4; ++m) _Pragma("unroll") for (int n = 0; n < 2; ++n) { \
        if constexpr (F8) asm volatile("v_mfma_f32_16x16x128_f8f6f4 %0, %1, %2, %0" : "+v"(acc[ai][bj][m][n]) : "v"(Bt[n]), "v"(At[m]));     \
        else { acc[ai][bj][m][n] = __builtin_amdgcn_mfma_f32_16x16x32_bf16(PG8_LO(Bt[n]), PG8_LO(At[m]), acc[ai][bj][m][n], 0, 0, 0); \
               acc[ai][bj][m][n] = __builtin_amdgcn_mfma_f32_16x16x32_bf16(PG8_HI(Bt[n]), PG8_HI(At[m]), acc[ai][bj][m][n], 0, 0, 0); } } __builtin_amdgcn_s_setprio(0); } while (0)
#define PG8_WAIT_V(n) asm volatile("s_waitcnt vmcnt(" #n ")" ::: "memory")
#define PG8_WAIT_L(n) asm volatile("s_waitcnt lgkmcnt(" #n ")" ::: "memory")
#define PG8_BAR __builtin_amdgcn_s_barrier()
#define PG8_SCHED __builtin_amdgcn_sched_barrier(0)
    Unit cur, nxt; int ui = 0, rs_pm = -1;
    if (!S.next(0, cur)) return;
    f32x4 acc[2][2][4][2];
#pragma unroll
    for (int a = 0; a < 2; ++a)
#pragma unroll
        for (int b = 0; b < 2; ++b)
#pragma unroll
            for (int m = 0; m < 4; ++m)
#pragma unroll
                for (int n = 0; n < 2; ++n) acc[a][b][m][n] = (f32x4){0.f, 0.f, 0.f, 0.f};
    v8i32 At[4], B0[2], B1[2];
    const char* cA = (const char*)g.A + (size_t)cur.pm * tstep; const char* cB = (const char*)g.Bt + (size_t)cur.pn * tstep + S.boff(cur);
    PG8_STAGE(PG8_SB(0, 0), cB, voffB); PG8_STAGE(PG8_SB(0, 1), cB + hstep, voffB); PG8_STAGE(PG8_SA(0, 0), cA, voffA); PG8_STAGE(PG8_SA(0, 1), cA + hstep, voffA);
    if (wr == 1) PG8_BAR;
    PG8_WAIT_V(2); PG8_BAR;
    PG8_STAGE(PG8_SB(1, 0), cB + kstep, voffB); PG8_STAGE(PG8_SA(1, 0), cA + kstep, voffA); PG8_STAGE(PG8_SB(1, 1), cB + hstep + kstep, voffB);
    PG8_WAIT_V(6); PG8_BAR;
    for (;;) {
        const bool has_next = S.next(ui + 1, nxt);
        const char* nA = has_next ? (const char*)g.A + (size_t)nxt.pm * tstep : cA; const char* nB = has_next ? (const char*)g.Bt + (size_t)nxt.pn * tstep + S.boff(nxt) : cB;
        for (int t = 0; t < nt; t += 2) {
            const bool last = (t == nt - 2);
            const char* a1 = cA + (size_t)(t + 1) * kstep;
            const char* a2 = last ? nA : cA + (size_t)(t + 2) * kstep; const char* b2 = last ? nB : cB + (size_t)(t + 2) * kstep;
            const char* a3 = a2 + kstep; const char* b3 = b2 + kstep;
            PG8_LDB(B0, 0, 0); PG8_LDB(B1, 0, 1); PG8_SCHED; PG8_LDA(At, 0, 0); PG8_STAGE(PG8_SA(1, 1), a1 + hstep, voffA);
            PG8_WAIT_V(8); PG8_WAIT_L(0); PG8_BAR; PG8_MMA(0, 0, At, B0); PG8_MMA(0, 1, At, B1); PG8_BAR; PG8_SCHED;
            PG8_LDA(At, 0, 1); PG8_STAGE(PG8_SB(0, 0), b2, voffB); PG8_STAGE(PG8_SB(0, 1), b2 + hstep, voffB); PG8_STAGE(PG8_SA(0, 0), a2, voffA);
            PG8_WAIT_V(8); PG8_WAIT_L(0); PG8_BAR; PG8_MMA(1, 0, At, B0); PG8_MMA(1, 1, At, B1); PG8_BAR; PG8_SCHED;
            PG8_LDB(B0, 1, 0); PG8_LDB(B1, 1, 1); PG8_SCHED; PG8_LDA(At, 1, 0); PG8_STAGE(PG8_SA(0, 1), a2 + hstep, voffA);
            PG8_WAIT_V(8); PG8_WAIT_L(0); PG8_BAR; PG8_MMA(0, 0, At, B0); PG8_MMA(0, 1, At, B1); PG8_BAR; PG8_SCHED;
            PG8_LDA(At, 1, 1); PG8_STAGE(PG8_SB(1, 0), b3, voffB); PG8_STAGE(PG8_SB(1, 1), b3 + hstep, voffB); PG8_STAGE(PG8_SA(1, 0), a3, voffA);
            PG8_WAIT_V(8); PG8_WAIT_L(0); PG8_BAR; PG8_MMA(1, 0, At, B0); PG8_MMA(1, 1, At, B1); PG8_BAR; PG8_SCHED;
        }
        if constexpr (F8) asm volatile("s_nop 15\n\ts_nop 15" ::: "memory");
        if (wr == 0) PG8_BAR;
        { int l2 = threadIdx.x; asm volatile("" : "+v"(l2));
          const PG8_LAS float* rsT = (const PG8_LAS float*)(lds + RS_LDS_OFF);
          if (Epi::ROWSCALE && cur.pm != rs_pm) {
              rs_pm = cur.pm;
              if (l2 < 256) { const f32x4* pr = (const f32x4*)(g.rss + (size_t)(cur.pm * BM + l2) * 32); f32x4 t = pr[0];
#pragma unroll
                  for (int q = 1; q < 8; ++q) t += pr[q];
                  ((PG8_LAS float*)(lds + RS_LDS_OFF))[l2] = rsqrtf(((t[0] + t[1]) + (t[2] + t[3])) * (1.f / 2048.f) + 1e-6f); }
              PG8_WAIT_L(0); PG8_BAR; asm volatile("" ::: "memory"); }
          E(acc, cur, wr, wc, l2 & 15, (l2 >> 4) & 3, rsT); }
        if (!has_next) break;
#pragma unroll
        for (int a = 0; a < 2; ++a)
#pragma unroll
            for (int b = 0; b < 2; ++b)
#pragma unroll
                for (int m = 0; m < 4; ++m)
#pragma unroll
                    for (int n = 0; n < 2; ++n) acc[a][b][m][n] = (f32x4){0.f, 0.f, 0.f, 0.f};
        cur = nxt; cA = nA; cB = nB; ++ui;
        if (wr == 1) PG8_BAR;
    }
    PG8_WAIT_V(0);
    PG8_BAR;
#undef PG8_SA
#undef PG8_SB
#undef PG8_STAGE
#undef PG8_LDA
#undef PG8_LDB
#undef PG8_MMA
#undef PG8_LD2
#undef PG8_LO
#undef PG8_HI
#undef PG8_WAIT_V
#undef PG8_WAIT_L
#undef PG8_BAR
#undef PG8_SCHED
}
}

constexpr int NTHR = 512, NWAVES = 8;
constexpr int LDS_BYTES = 147456;
constexpr int MISC_OFF = 135168;
constexpr int RQ_OUT = MISC_OFF + 2048;
static_assert(RQ_OUT + 64 * 144 <= LDS_BYTES, "output staging");

struct Ctx { int tid, lane, wave, gw, ngw; };

__device__ __forceinline__ void rope32(float& v0, float& v1, float pos, int lane) {
    const float o0 = __shfl_xor(v0, 8), o1 = __shfl_xor(v1, 8);
    if (lane < 16) {
        const int j0 = (2 * lane) & 15;
        const float i0 = __powf(500000.f, -(float)j0 * (1.f / 16.f)), i1 = __powf(500000.f, -(float)(j0 + 1) * (1.f / 16.f));
        const float s0 = __sinf(pos * i0), c0 = __cosf(pos * i0), s1 = __sinf(pos * i1), c1 = __cosf(pos * i1);
        if (lane < 8) { v0 = v0 * c0 - o0 * s0; v1 = v1 * c1 - o1 * s1; }
        else          { v0 = o0 * s0 + v0 * c0; v1 = o1 * s1 + v1 * c1; }
    }
}

template <bool F8 = false>
__device__ __forceinline__ void tr_seg(const float* __restrict__ W, int K, int Ns, int col0, int ncols, void* dstv, int mode, int p0, LAS float* scr, const Ctx& c, int& rot, float wscale = 1.f, const float* kg = nullptr) {
    bf16* dst = (bf16*)dstv;
    const int nnb = ncols / 64, nitems = (K / 64) * nnb;
    int it = c.gw - rot; if (it < 0) it += c.ngw;
    for (; it < nitems; it += c.ngw) {
        const int kb = it / nnb, nb = it - kb * nnb, k0 = kb * 64, n0 = nb * 64;
        const float* src = W + (size_t)k0 * Ns + col0 + n0 + c.lane;
#pragma unroll 16
        for (int i = 0; i < 64; ++i) scr[i * 65 + c.lane] = src[(size_t)i * Ns];
        LDS_WAIT(); asm volatile("" ::: "memory");
        const int ch = c.lane >> 3, nn = c.lane & 7;
        float gm[8];
#pragma unroll
        for (int i = 0; i < 8; ++i) gm[i] = wscale;
        if (kg) { const f32x4 ga = *(const f32x4*)(kg + k0 + 8 * ch), gb = *(const f32x4*)(kg + k0 + 8 * ch + 4); gm[0] *= ga.x; gm[1] *= ga.y; gm[2] *= ga.z; gm[3] *= ga.w; gm[4] *= gb.x; gm[5] *= gb.y; gm[6] *= gb.z; gm[7] *= gb.w; }
#pragma unroll
        for (int j = 0; j < 8; ++j) { const int n = nn + 8 * j; const LAS float* s = scr + (8 * ch) * 65 + n;
            const int ng = n0 + n, drow = mode ? ((ng >> 7) * 256 + p0 * 128 + (ng & 127)) : (p0 + ng);
            if constexpr (F8) { u32x2 o; o.x = pk4_fp8(s[0] * gm[0], s[65] * gm[1], s[130] * gm[2], s[195] * gm[3]); o.y = pk4_fp8(s[260] * gm[4], s[325] * gm[5], s[390] * gm[6], s[455] * gm[7]);
                *(u32x2*)((unsigned char*)dstv + (size_t)drow * K + k0 + 8 * ch) = o; }
            else { u32x4 o; o.x = pk2(s[0] * gm[0], s[65] * gm[1]); o.y = pk2(s[130] * gm[2], s[195] * gm[3]); o.z = pk2(s[260] * gm[4], s[325] * gm[5]); o.w = pk2(s[390] * gm[6], s[455] * gm[7]);
                *(u32x4*)(dst + (size_t)drow * K + k0 + 8 * ch) = o; } }
        LDS_WAIT(); asm volatile("" ::: "memory");
    }
    rot = (rot + nitems) % c.ngw;
}
__device__ __forceinline__ void x_row_bf16(const float* xrow, bf16* orow, float* rssrow, int lane) {
    const f32x4* xr = (const f32x4*)xrow + 2 * lane; f32x4 v[8]; float s = 0.f;
#pragma unroll
    for (int j = 0; j < 4; ++j) { v[2 * j] = xr[128 * j]; v[2 * j + 1] = xr[128 * j + 1]; }
#pragma unroll
    for (int j = 0; j < 8; ++j) s += (v[j].x * v[j].x + v[j].y * v[j].y) + (v[j].z * v[j].z + v[j].w * v[j].w);
    s = wave_sum(s);
#pragma unroll
    for (int j = 0; j < 4; ++j) { u32x4 w; w.x = pk2(v[2 * j].x, v[2 * j].y); w.y = pk2(v[2 * j].z, v[2 * j].w); w.z = pk2(v[2 * j + 1].x, v[2 * j + 1].y); w.w = pk2(v[2 * j + 1].z, v[2 * j + 1].w);
        ((u32x4*)orow)[64 * j + lane] = w; }
    if (lane < 32) rssrow[lane] = lane == 0 ? s : 0.f;
}
__device__ __forceinline__ void ph_prologue(KArgs a, LAS unsigned char* lds, const Ctx& c) {
    LAS float* scr = (LAS float*)(lds + c.wave * 16640);
    unsigned char* ws = a.ws; int rot = 0;
    bf16* wie = (bf16*)(ws + WS_WIE);
    tr_seg(a.in[I_WIE], DM, EVEN_IN, 0, 2560, wie, 0, 0, scr, c, rot, 1.f, a.in[I_NME]);
    tr_seg(a.in[I_WIE], DM, EVEN_IN, 2584, 3072, wie, 0, 2560, scr, c, rot, 1.f, a.in[I_NME]);
    tr_seg(a.in[I_WIE], DM, EVEN_IN, 5664, 1024, wie, 0, 5632, scr, c, rot, 1.f, a.in[I_NME]);
    tr_seg(a.in[I_WOE], DM, DM, 0, DM, (bf16*)(ws + WS_WOE), 0, 0, scr, c, rot);
    tr_seg(a.in[I_FG], DM, FFN, 0, FFN, ws + WS_WGU, 1, 0, scr, c, rot, 1.f, a.in[I_NFE]);
    tr_seg(a.in[I_FU], DM, FFN, 0, FFN, ws + WS_WGU, 1, 1, scr, c, rot, 1.f, a.in[I_NFE]);
    tr_seg(a.in[I_FD], FFN, DM, 0, DM, ws + WS_WD, 0, 0, scr, c, rot);
    tr_seg(a.in[I_WIO], DM, ODD_IN, 0, ODD_IN, (bf16*)(ws + WS_WIO), 0, 0, scr, c, rot, 1.f, a.in[I_NMO]);
    tr_seg(a.in[I_WOO], 2 * DM, DM, 0, DM, (bf16*)(ws + WS_WOO), 0, 0, scr, c, rot);
    for (int e = 0; e < NEXP; ++e) {
        tr_seg<true>(a.in[I_EG] + (size_t)e * DM * FFN, DM, FFN, 0, FFN, ws + WS_EGU + (size_t)e * 2 * FFN * DM, 1, 0, scr, c, rot, 64.f, a.in[I_NFO]);
        tr_seg<true>(a.in[I_EU] + (size_t)e * DM * FFN, DM, FFN, 0, FFN, ws + WS_EGU + (size_t)e * 2 * FFN * DM, 1, 1, scr, c, rot, 64.f, a.in[I_NFO]);
        tr_seg<true>(a.in[I_ED] + (size_t)e * DM * FFN, FFN, DM, 0, DM, ws + WS_ED + (size_t)e * FFN * DM, 0, 0, scr, c, rot, 64.f);
    }
    tr_seg(a.in[I_WCK], 32 * HD, HD, 0, HD, (bf16*)(ws + WS_WCK), 0, 0, scr, c, rot);
    tr_seg(a.in[I_WCV], 32 * HD, HD, 0, HD, (bf16*)(ws + WS_WCV), 0, 0, scr, c, rot);
    for (int idx = c.gw * 64 + c.lane; idx < 256 * DM; idx += c.ngw * 64) {
        const int r = idx / DM, k = idx - r * DM; float v = 0.f;
        if (r < 32) { const int sc = r < 24 ? 2560 + r : 5656 + (r - 24); v = a.in[I_WIE][(size_t)k * EVEN_IN + sc] * a.in[I_NME][k]; }
        wie[(size_t)(6656 + r) * DM + k] = (bf16)f2bf(v);
    }
    for (int o = c.gw; o < 256; o += c.ngw) { const int which = o >> 7, e = o & 127; const float* w = a.in[which ? I_WCV : I_WCK]; float s = 0.f;
        for (int k = c.lane; k < 32 * HD; k += 64) s += a.in[I_PE][k] * w[(size_t)k * HD + e];
        s = wave_sum(s); if (c.lane == 0) ((float*)(ws + WS_MISC + MS_PEW))[o] = s; }
    for (int m = c.gw; m < MTOK; m += c.ngw) x_row_bf16(a.in[I_X] + (size_t)m * DM, (bf16*)(ws + WS_H) + (size_t)m * DM, (float*)(ws + WS_RSS) + (size_t)m * 32, c.lane);
}
__device__ __forceinline__ void ph_prep0(KArgs a, const Ctx& c) {
    unsigned char* ws = a.ws; const bf16* Y0 = (const bf16*)(ws + WS_Y0); const int lane = c.lane;
    const float* qg = a.in[I_QG]; const float* kg = a.in[I_KG]; const int* posv = (const int*)a.in[I_POS]; const float* cw = a.in[I_CONV];
    const float qg0 = qg[2 * lane], qg1 = qg[2 * lane + 1], kg0 = kg[2 * lane], kg1 = kg[2 * lane + 1];
    const int j0 = (2 * lane) & 15;
    const float i0 = __powf(500000.f, -(float)j0 * (1.f / 16.f)), i1 = __powf(500000.f, -(float)(j0 + 1) * (1.f / 16.f));
    const int m0 = c.gw * 8;
#pragma unroll 2
    for (int m = m0; m < m0 + 8; ++m) {
        const bf16* yr = Y0 + (size_t)m * LDY0; const float pos = (float)posv[m];
        unsigned w[12];
#pragma unroll
        for (int hh = 0; hh < 12; ++hh) { const int scol = hh < 8 ? YQ + hh * HD : (hh < 10 ? YKS + (hh - 8) * HD : YKW + (hh - 10) * HD); w[hh] = *(const unsigned*)(yr + scol + 2 * lane); }
        const float s0 = __sinf(pos * i0), c0 = __cosf(pos * i0), s1 = __sinf(pos * i1), c1 = __cosf(pos * i1);
#pragma unroll
        for (int hh = 0; hh < 12; ++hh) {
            float v0 = lo16(w[hh]), v1 = hi16(w[hh]);
            const float r = rsqrtf(wave_sum(v0 * v0 + v1 * v1) * (1.f / HD) + RMS_EPS);
            v0 *= r * (hh < 8 ? qg0 : kg0); v1 *= r * (hh < 8 ? qg1 : kg1);
            const float o0 = __shfl_xor(v0, 8), o1 = __shfl_xor(v1, 8);
            if (lane < 8) { v0 = v0 * c0 - o0 * s0; v1 = v1 * c1 - o1 * s1; }
            else if (lane < 16) { v0 = o0 * s0 + v0 * c0; v1 = o1 * s1 + v1 * c1; }
            bf16* dst = hh < 8 ? (bf16*)(ws + WS_QN) + (size_t)m * 1024 + hh * HD : (hh < 10 ? (bf16*)(ws + WS_KSN) + (size_t)m * 256 + (hh - 8) * HD : (bf16*)(ws + WS_KWN) + (size_t)m * 256 + (hh - 10) * HD);
            *(unsigned*)(dst + 2 * lane) = pk2(v0, v1);
        }
    }
    const bool hist = (m0 & (SEQ - 1)) > 0;
#pragma unroll 1
    for (int j = 0; j < 4; ++j) { const int ch = 8 * (lane + 64 * j);
        f32x4 wa[4], wb[4];
#pragma unroll
        for (int i = 0; i < 4; ++i) { wa[i] = *(const f32x4*)(cw + i * 2048 + ch); wb[i] = *(const f32x4*)(cw + i * 2048 + ch + 4); }
        const bf16* col = Y0 + (size_t)m0 * LDY0 + YMQ + ch;
        u32x4 x0 = (u32x4){0u, 0u, 0u, 0u}, x1 = x0, x2 = x0;
        if (hist) { x0 = *(const u32x4*)(col - 3 * (ptrdiff_t)LDY0); x1 = *(const u32x4*)(col - 2 * (ptrdiff_t)LDY0); x2 = *(const u32x4*)(col - (ptrdiff_t)LDY0); }
        const float sc = ch >= 1024 ? 0.0625f : 1.f;
        bf16* dstc = ch >= 1024 ? (bf16*)(ws + WS_MK) + (size_t)m0 * 1024 + (ch - 1024) : (bf16*)(ws + WS_MQ) + (size_t)m0 * 1024 + ch;
        u32x4 xr[8];
#pragma unroll
        for (int i = 0; i < 8; ++i) xr[i] = *(const u32x4*)(col + (size_t)i * LDY0);
#pragma unroll
        for (int i = 0; i < 8; ++i) { const u32x4 x3 = xr[i]; float acc[8];
#pragma unroll
            for (int e = 0; e < 8; ++e) acc[e] = 0.f;
#define CONV_TAP(XV, k) acc[0] += lo16(XV.x) * wa[k].x; acc[1] += hi16(XV.x) * wa[k].y; acc[2] += lo16(XV.y) * wa[k].z; acc[3] += hi16(XV.y) * wa[k].w; acc[4] += lo16(XV.z) * wb[k].x; acc[5] += hi16(XV.z) * wb[k].y; acc[6] += lo16(XV.w) * wb[k].z; acc[7] += hi16(XV.w) * wb[k].w;
            CONV_TAP(x0, 0) CONV_TAP(x1, 1) CONV_TAP(x2, 2) CONV_TAP(x3, 3)
#undef CONV_TAP
#pragma unroll
            for (int e = 0; e < 8; ++e) acc[e] = siluf_(acc[e]) * sc;
            u32x4 o; o.x = pk2(acc[0], acc[1]); o.y = pk2(acc[2], acc[3]); o.z = pk2(acc[4], acc[5]); o.w = pk2(acc[6], acc[7]);
            *(u32x4*)(dstc + (size_t)i * 1024) = o;
            x0 = x1; x1 = x2; x2 = x3; }
    }
}
__device__ __forceinline__ void ph_compress(KArgs a, LAS unsigned char* lds, const Ctx& c) {
    unsigned char* ws = a.ws; const bf16* Y0 = (const bf16*)(ws + WS_Y0); const int lane = c.lane, wave = c.wave;
    const int* posv = (const int*)a.in[I_POS];
    LAS unsigned char* At = lds;
    LAS float* Ot = (LAS float*)(lds + 272 * 272);
    for (int u = blockIdx.x; u < 256; u += gridDim.x) {
        const int which = u >> 7, b = (u >> 5) & 3, g = (u >> 4) & 1, cb = u & 15, t0 = cb * 256;
        const int scol = (which ? YVC : YKC) + g * HD;
        __syncthreads();
        for (int idx = c.tid; idx < 272 * 16; idx += NTHR) { const int r = idx >> 4, q = idx & 15; const int t = t0 + r;
            u32x4 v = (u32x4){0u, 0u, 0u, 0u}; if (t < SEQ) v = *(const u32x4*)(Y0 + (size_t)(b * SEQ + t) * LDY0 + scol + q * 8);
            *(LAS u32x4*)(At + r * 272 + q * 16) = v; }
        __syncthreads();
        const bf16* Wt = (const bf16*)(ws + (which ? WS_WCV : WS_WCK));
        const int fr = lane & 15, fq = lane >> 4, e = wave * 16 + fr;
        f32x4 acc = (f32x4){0.f, 0.f, 0.f, 0.f};
        const bf16* wrow = Wt + (size_t)e * 4096 + fq * 8;
#pragma unroll 16
        for (int s = 0; s < 128; ++s) {
            const bf16x8 bfr = *(const bf16x8*)(wrow + s * 32);
            const bf16x8 afr = *(const LAS bf16x8*)(At + (16 * fr + (s >> 2)) * 272 + ((s & 3) * 32 + fq * 8) * 2);
            acc = __builtin_amdgcn_mfma_f32_16x16x32_bf16(afr, bfr, acc, 0, 0, 0);
        }
        const float pw = ((const float*)(ws + WS_MISC + MS_PEW))[which * 128 + e];
#pragma unroll
        for (int r = 0; r < 4; ++r) Ot[(4 * fq + r) * 128 + e] = acc[r] + pw;
        __syncthreads();
#pragma unroll
        for (int rr = 0; rr < 2; ++rr) { const int cl = 2 * wave + rr, cg = cb * 16 + cl;
            float v0 = Ot[cl * 128 + 2 * lane], v1 = Ot[cl * 128 + 2 * lane + 1];
            bf16* dst = (bf16*)(ws + (which ? WS_VCC : WS_KCN)) + ((size_t)((b * 2 + g) * 256 + cg)) * HD + 2 * lane;
            if (cg >= NC) { v0 = 0.f; v1 = 0.f; }
            else if (!which) { const float r = rsqrtf(wave_sum(v0 * v0 + v1 * v1) * (1.f / HD) + RMS_EPS); v0 *= r * a.in[I_KG][2 * lane]; v1 *= r * a.in[I_KG][2 * lane + 1];
                rope32(v0, v1, (float)posv[b * SEQ + 31 + 16 * cg], lane); }
            *(unsigned*)dst = pk2(v0, v1); }
        if (which && c.tid < 128) {
            const int d = c.tid; unsigned w[8];
#pragma unroll
            for (int k = 0; k < 8; ++k) { const float a0 = (cb * 16 + 2 * k) < NC ? Ot[(2 * k) * 128 + d] : 0.f, a1 = (cb * 16 + 2 * k + 1) < NC ? Ot[(2 * k + 1) * 128 + d] : 0.f; w[k] = pk2(a0, a1); }
            u32x4* dstT = (u32x4*)((bf16*)(ws + WS_VCT) + ((size_t)((b * 2 + g) * 128 + d)) * 256 + cb * 16);
            dstT[0] = (u32x4){w[0], w[1], w[2], w[3]}; dstT[1] = (u32x4){w[4], w[5], w[6], w[7]}; }
    }
}

__device__ __forceinline__ void ph_vtrans(KArgs a, LAS unsigned char* lds, const Ctx& c) {
    unsigned char* ws = a.ws; const bf16* Y0 = (const bf16*)(ws + WS_Y0);
    for (int u = blockIdx.x; u < 1024; u += gridDim.x) {
        const int tb = u & 63, g = (u >> 6) & 1, b = (u >> 7) & 3, which = u >> 9;
        const int scol = (which ? YVW : YVS) + g * HD; bf16* dst = (bf16*)(ws + (which ? WS_VWT : WS_VST)) + (size_t)((b * 2 + g) * 128) * SEQ + tb * 64;
        __syncthreads();
        { const int t = c.tid >> 3, q = c.tid & 7; const bf16* src = Y0 + (size_t)(b * SEQ + tb * 64 + t) * LDY0 + scol + q * 16;
          const u32x4 v0 = *(const u32x4*)src, v1 = *(const u32x4*)(src + 8);
          *(LAS u32x4*)(lds + t * 272 + q * 32) = v0; *(LAS u32x4*)(lds + t * 272 + q * 32 + 16) = v1; }
        __syncthreads();
        { const int d = c.tid >> 2, tq = c.tid & 3; unsigned w[8];
#pragma unroll
          for (int k = 0; k < 8; ++k) { const unsigned lo = *(const LAS unsigned short*)(lds + (tq * 16 + 2 * k) * 272 + d * 2), hi = *(const LAS unsigned short*)(lds + (tq * 16 + 2 * k + 1) * 272 + d * 2); w[k] = lo | (hi << 16); }
          u32x4* o = (u32x4*)(dst + (size_t)d * SEQ + tq * 16); o[0] = (u32x4){w[0], w[1], w[2], w[3]}; o[1] = (u32x4){w[4], w[5], w[6], w[7]}; }
    }
}

typedef float f32x16 __attribute__((ext_vector_type(16)));
typedef short s16x4 __attribute__((ext_vector_type(4)));
__device__ __forceinline__ s16x4 lds_tr16(const LAS unsigned char* p) { typedef short v4i16_t __attribute__((ext_vector_type(4))); return __builtin_bit_cast(s16x4, __builtin_amdgcn_ds_read_tr16_b64_v4i16((LAS v4i16_t*)p)); }
constexpr int NSA_BUF = 32768, NSA_IMP_OFF = 65536, NSA_MASK_OFF = NSA_IMP_OFF + 64 * 65 * 4;
__device__ __forceinline__ void nsa_issue(LAS unsigned char* buf, const char* kbase, size_t kstride, const char* vbase, size_t vstride, int wave, int lane) {
#pragma unroll
    for (int i = 0; i < 2; ++i) { const int q = wave * 2 + i, row = 4 * q + (lane >> 4), ch = (lane & 15) ^ (row & 15);
        __builtin_amdgcn_global_load_lds((const unsigned*)(kbase + (size_t)row * kstride + ch * 16), (LAS unsigned*)(buf + q * 1024), 16, 0, 0); }
#pragma unroll
    for (int i = 0; i < 2; ++i) { const int q = wave * 2 + i, row = 8 * q + (lane >> 3), ch = (lane & 7) ^ (row & 7);
        __builtin_amdgcn_global_load_lds((const unsigned*)(vbase + (size_t)row * vstride + ch * 16), (LAS unsigned*)(buf + 16384 + q * 1024), 16, 0, 0); }
}
__device__ __forceinline__ void nsa_scores(f32x16& p, const LAS unsigned char* buf, int ln, const bf16x8 (&Q)[8], int hh) {
    const int r = ln & 31, x0 = (r & 15) ^ (ln >> 5); const LAS unsigned char* kb = buf + r * 256 + hh * 8192;
#pragma unroll
    for (int i = 0; i < 16; ++i) p[i] = 0.f;
#pragma unroll
    for (int s = 0; s < 8; ++s) { const bf16x8 a0 = *(const LAS bf16x8*)(kb + (((2 * s) ^ x0) << 4));
        p = __builtin_amdgcn_mfma_f32_32x32x16_bf16(a0, Q[s], p, 0, 0, 0);
        if ((s & 3) == 3) __builtin_amdgcn_sched_barrier(0); }
}
__device__ __forceinline__ float half_max(float m) { auto rr = __builtin_amdgcn_permlane32_swap(__float_as_uint(m), __float_as_uint(m), false, false); return fmaxf(__uint_as_float(rr[0]), __uint_as_float(rr[1])); }
__device__ __forceinline__ float half_sum(float m) { auto rr = __builtin_amdgcn_permlane32_swap(__float_as_uint(m), __float_as_uint(m), false, false); return __uint_as_float(rr[0]) + __uint_as_float(rr[1]); }
__device__ __forceinline__ float tile_max(const f32x16& p) {
    float a = fmaxf(p[0], p[1]);
#pragma unroll
    for (int i = 2; i < 16; ++i) a = fmaxf(a, p[i]);
    return half_max(a);
}
__device__ __forceinline__ bf16x8 pack8(const f32x16& p, int o) {
    u32x4 w; w.x = pg8::cvt_pk_bf16(p[o], p[o + 1]); w.y = pg8::cvt_pk_bf16(p[o + 2], p[o + 3]); w.z = pg8::cvt_pk_bf16(p[o + 4], p[o + 5]); w.w = pg8::cvt_pk_bf16(p[o + 6], p[o + 7]);
    return __builtin_bit_cast(bf16x8, w);
}
__device__ __forceinline__ void nsa_pv(f32x16 (&O)[4], const LAS unsigned char* buf, int ln, const f32x16& p, int hh) {
    const int r = ln & 31, xv = r & 7; const LAS unsigned char* vb = buf + 16384 + r * 128 + 8 * (ln >> 5);
    bf16x8 P[2]; P[0] = pack8(p, 0); P[1] = pack8(p, 8);
#pragma unroll
    for (int dt = 0; dt < 4; ++dt) {
#pragma unroll
        for (int s2 = 0; s2 < 2; ++s2) { const int s = 2 * hh + s2; const s16x4 lo = *(const LAS s16x4*)(vb + dt * 4096 + (((2 * s) ^ xv) << 4)), hi = *(const LAS s16x4*)(vb + dt * 4096 + (((2 * s + 1) ^ xv) << 4));
            const bf16x8 av = (bf16x8){lo[0], lo[1], lo[2], lo[3], hi[0], hi[1], hi[2], hi[3]};
            O[dt] = __builtin_amdgcn_mfma_f32_32x32x16_bf16(av, P[s2], O[dt], 0, 0, 0); }
        if (dt & 1) __builtin_amdgcn_sched_barrier(0); }
}
__device__ __forceinline__ void nsa_mask(f32x16& p, int kb, int klo, int khi) {
#pragma unroll
    for (int i = 0; i < 16; ++i) { const int k = kb + (i & 3) + 8 * (i >> 2); if (k < klo || k > khi) p[i] = -3.0e38f; }
}
__device__ __forceinline__ void nsa_step(f32x16& p, float bias, float c2, float& m, float& l, f32x16 (&O)[4], const LAS unsigned char* buf, int ln, int hh) {
    const float tm = tile_max(p) * c2 + bias;
    if (__builtin_amdgcn_ballot_w64(tm > m + 8.f) != 0ull) {
        const float mn = fmaxf(m, tm), alpha = __builtin_amdgcn_exp2f(m - mn); l *= alpha; m = mn;
#pragma unroll
        for (int dt = 0; dt < 4; ++dt)
#pragma unroll
            for (int i = 0; i < 16; ++i) O[dt][i] *= alpha; }
    const float nb = bias - m; float rs = 0.f;
#pragma unroll
    for (int i = 0; i < 16; ++i) { p[i] = __builtin_amdgcn_exp2f(fmaf(p[i], c2, nb)); rs += p[i]; }
    l += half_sum(rs);
    nsa_pv(O, buf, ln, p, hh);
}
template <bool ACC> __device__ __forceinline__ void nsa_out(bf16* orow0, int hf, const f32x16 (&O)[4], float w) {
#pragma unroll
    for (int dt = 0; dt < 4; ++dt)
#pragma unroll
        for (int m2 = 0; m2 < 2; ++m2) { float A[4], B[4];
#pragma unroll
            for (int j = 0; j < 4; ++j) { const auto rr = __builtin_amdgcn_permlane32_swap(__float_as_uint(O[dt][8 * m2 + j] * w), __float_as_uint(O[dt][8 * m2 + 4 + j] * w), false, false); A[j] = __uint_as_float(rr[0]); B[j] = __uint_as_float(rr[1]); }
            u32x4* ptr = (u32x4*)(orow0 + 32 * dt + 16 * m2 + 8 * hf);
            if (ACC) { const u32x4 old = *ptr; A[0] += lo16(old.x); A[1] += hi16(old.x); A[2] += lo16(old.y); A[3] += hi16(old.y); B[0] += lo16(old.z); B[1] += hi16(old.z); B[2] += lo16(old.w); B[3] += hi16(old.w); }
            u32x4 o; o.x = pg8::cvt_pk_bf16(A[0], A[1]); o.y = pg8::cvt_pk_bf16(A[2], A[3]); o.z = pg8::cvt_pk_bf16(B[0], B[1]); o.w = pg8::cvt_pk_bf16(B[2], B[3]); *ptr = o; }
}
#define NSA_SYNC() do { asm volatile("s_waitcnt vmcnt(0) lgkmcnt(0)" ::: "memory"); __builtin_amdgcn_s_barrier(); asm volatile("" ::: "memory"); } while (0)
#define NSA_ZERO_O() do { _Pragma("unroll") for (int dt = 0; dt < 4; ++dt) _Pragma("unroll") for (int i = 0; i < 16; ++i) O[dt][i] = 0.f; } while (0)

__device__ __forceinline__ void ph_nsa(KArgs a, LAS unsigned char* lds, const Ctx& c) {
    unsigned char* ws = a.ws; const int wave = c.wave, p = wave & 3, th = wave >> 2;
    const bf16* Y0 = (const bf16*)(ws + WS_Y0); const bf16* QN = (const bf16*)(ws + WS_QN); bf16* MIXED = (bf16*)(ws + WS_MIXED);
    LAS unsigned* imp = (LAS unsigned*)(lds + NSA_IMP_OFF); LAS unsigned long long* msk = (LAS unsigned long long*)(lds + NSA_MASK_OFF);
    const float c2 = 0.08838834764831845f * 1.4426950408889634f;
    unsigned* qhead = (unsigned*)(ws + WS_CTL) + CW_NSAQ;
    LAS unsigned* qslot = (LAS unsigned*)(lds + NSA_MASK_OFF + 512);
    for (;;) {
        __syncthreads();
        if (threadIdx.x == 0) {
            unsigned got = 0xffffffffu;
            for (int k = 0; k < 8 && got == 0xffffffffu; ++k) { const unsigned q = (blockIdx.x + k) & 7u;
                if (__hip_atomic_load(qhead + 64 * q, __ATOMIC_RELAXED, __HIP_MEMORY_SCOPE_AGENT) < 64u) { const unsigned i = __hip_atomic_fetch_add(qhead + 64 * q, 1u, __ATOMIC_RELAXED, __HIP_MEMORY_SCOPE_AGENT); if (i < 64u) got = i * 8u + q; } }
            qslot[0] = got; }
        __syncthreads();
        const int wi = (int)qslot[0]; if (wi < 0) break;
        int tid_o = threadIdx.x; asm volatile("" : "+v"(tid_o)); const int lane = tid_o & 63;
        const int r = lane & 31, h = lane >> 5;
        const int bg = wi & 7, qc = 63 - (wi >> 3), b = bg >> 1, g = bg & 1, t0 = qc * 64;
        const int tq = t0 + 32 * th + r; const size_t m = (size_t)b * SEQ + tq;
        const char* KC = (const char*)(ws + WS_KCN) + (size_t)bg * 256 * 256; const char* VCT = (const char*)(ws + WS_VCT) + (size_t)bg * 128 * 512;
        const char* KS = (const char*)(ws + WS_KSN) + ((size_t)b * SEQ * 256 + g * HD) * 2; const char* VST = (const char*)(ws + WS_VST) + (size_t)bg * 128 * SEQ * 2;
        const char* KW = (const char*)(ws + WS_KWN) + ((size_t)b * SEQ * 256 + g * HD) * 2; const char* VWT = (const char*)(ws + WS_VWT) + (size_t)bg * 128 * SEQ * 2;
        __syncthreads();
        for (int i = tid_o; i < 64 * 65; i += NTHR) imp[i] = 0u;
        bf16x8 Q[8];
#pragma unroll
        for (int s = 0; s < 8; ++s) Q[s] = *(const bf16x8*)(QN + m * 1024 + (g * 4 + p) * HD + 16 * s + 8 * h);
#define NSA_ROW(lnv) ((size_t)b * SEQ + t0 + 32 * th + ((lnv) & 31))
#define NSA_GATE(k, lnv) sigmoidf_(bf2f(Y0[NSA_ROW(lnv) * LDY0 + YG + (g * 4 + p) * 3 + (k)]))
#define NSA_OROW(lnv) (MIXED + NSA_ROW(lnv) * DM + (g * 4 + p) * HD)
        f32x16 O[4]; f32x16 pp;
        const int nct = (4 * qc + 3 + 63) >> 6;
        const int chi = tq >= 31 ? (tq - 31) >> 4 : -1;
        float mA = -1e30f, lA = 0.f;
        nsa_issue(lds, KC, 256, VCT, 512, wave, lane);
        for (int it = 0; it < nct; ++it) {
            LAS unsigned char* buf = lds + (it & 1) * NSA_BUF;
            int ln = lane; asm volatile("" : "+v"(ln));
            NSA_SYNC();
            { const int cn = it + 1 < nct ? it + 1 : it + 1 - nct; nsa_issue(lds + ((it + 1) & 1) * NSA_BUF, KC + (size_t)cn * 64 * 256, 256, VCT + cn * 128, 512, wave, ln); }
#pragma unroll
            for (int hh = 0; hh < 2; ++hh) {
                nsa_scores(pp, buf, ln, Q, hh);
                nsa_mask(pp, it * 64 + 32 * hh + 4 * (ln >> 5), 0, chi);
                const float tm = tile_max(pp) * c2, mn = fmaxf(mA, tm); float rs = 0.f;
#pragma unroll
                for (int i = 0; i < 16; ++i) rs += __builtin_amdgcn_exp2f(fmaf(pp[i], c2, -mn));
                lA = lA * __builtin_amdgcn_exp2f(mA - mn) + half_sum(rs); mA = mn;
            }
        }
        NSA_ZERO_O();
        for (int it = nct; it < 2 * nct; ++it) {
            const int ct = it - nct; LAS unsigned char* buf = lds + (it & 1) * NSA_BUF;
            int ln = lane; asm volatile("" : "+v"(ln));
            NSA_SYNC();
            if (it + 1 < 2 * nct) { const int cn = it + 1 - nct; nsa_issue(lds + ((it + 1) & 1) * NSA_BUF, KC + (size_t)cn * 64 * 256, 256, VCT + cn * 128, 512, wave, ln); }
#pragma unroll
            for (int hh = 0; hh < 2; ++hh) {
                nsa_scores(pp, buf, ln, Q, hh);
                nsa_mask(pp, ct * 64 + 32 * hh + 4 * (ln >> 5), 0, chi);
                const float inv = lA > 0.f ? 1.f / lA : 0.f;
#pragma unroll
                for (int i = 0; i < 16; ++i) pp[i] = pp[i] > -1.0e38f ? __builtin_amdgcn_exp2f(fmaf(pp[i], c2, -mA)) * inv : 0.f;
                LAS unsigned* irow = imp + (32 * th + (ln & 31)) * 65 + ct * 16 + 8 * hh + (ln >> 5);
#pragma unroll
                for (int rg = 0; rg < 4; ++rg) {
                    const float s0 = (pp[4 * rg] + pp[4 * rg + 1]) + (pp[4 * rg + 2] + pp[4 * rg + 3]);
                    __hip_atomic_fetch_add(irow + 2 * rg, (unsigned)(s0 * 536870912.f + 0.5f), __ATOMIC_RELAXED, __HIP_MEMORY_SCOPE_WORKGROUP);
                    if (ct * 16 + 8 * hh + (ln >> 5) + 2 * rg + 1 < 64) __hip_atomic_fetch_add(irow + 2 * rg + 1, (unsigned)(pp[4 * rg + 3] * 536870912.f + 0.5f), __ATOMIC_RELAXED, __HIP_MEMORY_SCOPE_WORKGROUP);
                }
                nsa_pv(O, buf, ln, pp, hh);
            }
        }
        { int l2 = lane; asm volatile("" : "+v"(l2)); nsa_out<false>(NSA_OROW(l2), l2 >> 5, O, NSA_GATE(0, l2)); }
        NSA_SYNC();
#pragma unroll 1
        for (int tt = 0; tt < 8; ++tt) { const int t = wave * 8 + tt; const LAS unsigned* row = imp + t * 65;
            const bool forced = (lane == 0) || (lane == qc) || (lane == qc - 1); const unsigned v = forced ? 0xffffffffu : row[lane]; int rank = 0;
#pragma unroll 4
            for (int i = 0; i <= qc; ++i) { const unsigned vi = (unsigned)__builtin_amdgcn_readlane((int)v, i); rank += (vi > v || (vi == v && i < lane)) ? 1 : 0; }
            const unsigned long long mk = __ballot(lane <= qc && rank < 16); if (lane == 0) msk[t] = mk; }
        nsa_issue(lds, KS, 512, VST, (size_t)SEQ * 2, wave, lane);
        NSA_SYNC();
        const unsigned long long mymask = msk[32 * th + r];
        {
            float mS = -1e30f, lS = 0.f;
            NSA_ZERO_O();
            for (int j = 0; j <= qc; ++j) {
                int ln = lane; asm volatile("" : "+v"(ln));
                if (j > 0) NSA_SYNC();
                if (j < qc) nsa_issue(lds + ((j + 1) & 1) * NSA_BUF, KS + (size_t)(j + 1) * 64 * 512, 512, VST + (size_t)(j + 1) * 128, (size_t)SEQ * 2, wave, ln);
                const float bias = ((mymask >> j) & 1ull) ? 0.f : -1e30f;
#pragma unroll
                for (int hh = 0; hh < 2; ++hh) {
                    nsa_scores(pp, lds + (j & 1) * NSA_BUF, ln, Q, hh);
                    if (j == qc) nsa_mask(pp, j * 64 + 32 * hh + 4 * (ln >> 5), 0, t0 + 32 * th + (ln & 31));
                    nsa_step(pp, bias, c2, mS, lS, O, lds + (j & 1) * NSA_BUF, ln, hh);
                }
            }
            int l2 = lane; asm volatile("" : "+v"(l2)); nsa_out<true>(NSA_OROW(l2), l2 >> 5, O, NSA_GATE(1, l2) / lS);
        }
        {
            const int j0 = qc >= 8 ? qc - 8 : 0;
            NSA_SYNC();
            nsa_issue(lds + (j0 & 1) * NSA_BUF, KW + (size_t)j0 * 64 * 512, 512, VWT + (size_t)j0 * 128, (size_t)SEQ * 2, wave, lane);
            float mW = -1e30f, lW = 0.f;
            NSA_ZERO_O();
            for (int j = j0; j <= qc; ++j) {
                int ln = lane; asm volatile("" : "+v"(ln));
                NSA_SYNC();
                if (j < qc) nsa_issue(lds + ((j + 1) & 1) * NSA_BUF, KW + (size_t)(j + 1) * 64 * 512, 512, VWT + (size_t)(j + 1) * 128, (size_t)SEQ * 2, wave, ln);
#pragma unroll
                for (int hh = 0; hh < 2; ++hh) {
                    nsa_scores(pp, lds + (j & 1) * NSA_BUF, ln, Q, hh);
                    if (j == qc || j == qc - 8) { const int tql = t0 + 32 * th + (ln & 31); nsa_mask(pp, j * 64 + 32 * hh + 4 * (ln >> 5), tql - 511, tql); }
                    nsa_step(pp, 0.f, c2, mW, lW, O, lds + (j & 1) * NSA_BUF, ln, hh);
                }
            }
            int l2 = lane; asm volatile("" : "+v"(l2)); nsa_out<true>(NSA_OROW(l2), l2 >> 5, O, NSA_GATE(2, l2) / lW);
        }
    }
}

constexpr size_t MLG_A = WS_SB + 8 * MiB, MLG_P = MLG_A + 256 * 1024, MLG_AL = MLG_P + 256 * 1024, MLG_RS = MLG_AL + 256 * 1024, MLG_KBAR = WS_SB + 9 * MiB;
__device__ __forceinline__ void ph_ml_s(KArgs a, LAS unsigned char* lds, const Ctx& c) {
    unsigned char* ws = a.ws; const bf16* Y0 = (const bf16*)(ws + WS_Y0); const bf16* MQ = (const bf16*)(ws + WS_MQ); const bf16* MK = (const bf16*)(ws + WS_MK); bf16* SA = (bf16*)(ws + WS_SB);
    float* GA = (float*)(ws + MLG_A); float* GP = (float*)(ws + MLG_P); float* GAL = (float*)(ws + MLG_AL); float* GRS = (float*)(ws + MLG_RS); float* KBAR = (float*)(ws + MLG_KBAR);
    const int lane = c.lane, wave = c.wave, r = lane & 31, hf = lane >> 5, sub = wave >> 2, st = (wave >> 1) & 1, tt = wave & 1;
    LAS unsigned char* qT = lds + sub * 67584; LAS unsigned char* kT = qT + 33792;
    LAS float* alph = (LAS float*)(lds + MISC_OFF + 64) + sub * 128;
    for (int it = blockIdx.x; it < BATCH * ML_H * 32; it += gridDim.x) {
        const int u = 2 * it + sub, ch = u & 63, bh = u >> 6, h = bh & 3, b = bh >> 2; const size_t m0 = (size_t)b * SEQ + ch * 64;
        __syncthreads();
#pragma unroll
        for (int i = 0; i < 8; ++i) { const int idx = (c.tid & 255) + 256 * i, row = idx >> 5, q = idx & 31;
            *(LAS u32x4*)(qT + row * 528 + q * 16) = *(const u32x4*)(MQ + (m0 + row) * 1024 + h * 256 + q * 8);
            *(LAS u32x4*)(kT + row * 528 + q * 16) = *(const u32x4*)(MK + (m0 + row) * 1024 + h * 256 + q * 8); }
        if ((wave & 3) == 0) {
            const float ig = bf2f(Y0[(m0 + lane) * LDY0 + YI + h]); const float f = bf2f(Y0[(m0 + lane) * LDY0 + YF + h]) + a.in[I_FB][h];
            const float lf = fminf(f, 0.f) - log1pf(__expf(-fabsf(f)));
            float av = lf;
#pragma unroll
            for (int o = 1; o < 64; o <<= 1) { const float t2 = __shfl_up(av, o); if (lane >= o) av += t2; }
            const float uv = ig - av; float pmv = uv;
#pragma unroll
            for (int o = 1; o < 64; o <<= 1) { const float t2 = __shfl_up(pmv, o); if (lane >= o) pmv = fmaxf(pmv, t2); }
            const float al = __expf(uv - __shfl(pmv, 63));
            alph[lane] = al; alph[64 + lane] = 0.f;
            const size_t gi = (size_t)bh * SEQ + ch * 64 + lane; GA[gi] = av; GP[gi] = pmv; GAL[gi] = al;
        }
        __syncthreads();
        f32x16 acc;
#pragma unroll
        for (int i = 0; i < 16; ++i) acc[i] = 0.f;
        if (tt >= st) {
            const LAS unsigned char* ka = kT + (32 * st + r) * 528 + hf * 16; const LAS unsigned char* qa = qT + (32 * tt + r) * 528 + hf * 16;
#pragma unroll
            for (int ks = 0; ks < 16; ++ks) acc = __builtin_amdgcn_mfma_f32_32x32x16_bf16(*(const LAS bf16x8*)(ka + ks * 32), *(const LAS bf16x8*)(qa + ks * 32), acc, 0, 0, 0);
        }
        const int t = 32 * tt + r; float rsum = 0.f;
        bf16* srow = SA + (size_t)u * 4096 + t * 64 + 32 * st + 4 * hf;
#pragma unroll
        for (int q4 = 0; q4 < 4; ++q4) { const f32x4 al4 = *(const LAS f32x4*)(alph + 32 * st + 8 * q4 + 4 * hf); float v[4];
#pragma unroll
            for (int j = 0; j < 4; ++j) { const int s = 32 * st + 8 * q4 + 4 * hf + j; v[j] = t >= s ? acc[4 * q4 + j] * al4[j] : 0.f; }
            u32x2 o; o.x = pg8::cvt_pk_bf16(v[0], v[1]); o.y = pg8::cvt_pk_bf16(v[2], v[3]); *(u32x2*)(srow + 8 * q4) = o;
            rsum += (lo16(o.x) + hi16(o.x)) + (lo16(o.y) + hi16(o.y)); }
        rsum = half_sum(rsum);
        if (hf == 0 && tt >= st) __hip_atomic_fetch_add(alph + 64 + t, rsum, __ATOMIC_RELAXED, __HIP_MEMORY_SCOPE_WORKGROUP);
        { const int d = c.tid & 255; float kb = 0.f;
#pragma unroll 8
          for (int s = 0; s < 64; ++s) kb += alph[s] * bf2f(*(const LAS unsigned short*)(kT + s * 528 + d * 2));
          KBAR[(size_t)u * 256 + d] = kb; }
        __syncthreads();
        if ((wave & 3) == 0) GRS[(size_t)bh * SEQ + ch * 64 + lane] = alph[64 + lane];
    }
}
constexpr int MQ_Q = 0, MQ_K = 33792, MQ_V = MQ_K + 64 * 544, MQ_VZ = MQ_V + 4608, MQ_S = MQ_VZ + 4608, MQ_C = MQ_S + 9216, MQ_N = MQ_C + 16896, MQ_END = MQ_N + 1024;
constexpr int MQ_OUT = 106496;
constexpr int MQ_NB = MQ_OUT + 64 * 144;
constexpr int MQ_QN = MQ_NB + 512;
constexpr int MQ_OUT2 = MQ_QN + 256;
static_assert(MQ_END <= MQ_OUT && MQ_OUT2 + 64 * 144 <= MISC_OFF, "mLSTM LDS map");
template <int ROLE> __device__ __forceinline__ void ml_q_loop(LAS unsigned char* lds, int tid0, int wave, unsigned char* ws, int b, int h, int es, int bh) {
    asm volatile("" : "+v"(tid0));
    const bf16* Y0 = (const bf16*)(ws + WS_Y0); const bf16* MQ = (const bf16*)(ws + WS_MQ); const bf16* MK = (const bf16*)(ws + WS_MK); const bf16* SA = (const bf16*)(ws + WS_SB);
    const float* gbase = (const float*)(ws + MLG_A) + (size_t)bh * SEQ; const float* pbase = (const float*)(ws + MLG_P) + (size_t)bh * SEQ; const float* albase = (const float*)(ws + MLG_AL) + (size_t)bh * SEQ; const float* rsbase = (const float*)(ws + MLG_RS) + (size_t)bh * SEQ;
    float* HRAW = (float*)(ws + WS_HRAW);
    LAS float* nS = (LAS float*)(lds + MQ_N);
    const bf16* qsrc; const bf16* ksrc; const bf16* vsrc; const bf16* ssrc; const float* alsrc; const float* kbsrc; int tok0;
    {   const int tid = tid0, prow = tid >> 5, pq = tid & 31, vrow = tid >> 3, vq = tid & 7;
        qsrc = MQ + ((size_t)b * SEQ + prow) * 1024 + h * 256 + pq * 8; ksrc = MK + ((size_t)b * SEQ + prow) * 1024 + h * 256 + pq * 8;
        vsrc = Y0 + ((size_t)b * SEQ + (tid >> 2)) * LDY0 + YMV + h * 256 + es * 32 + (tid & 3) * 8; ssrc = SA + ((size_t)bh * 64) * 4096 + vrow * 64 + vq * 8;
        alsrc = albase + (tid >> 2); kbsrc = (const float*)(ws + MLG_KBAR) + (size_t)bh * 64 * 256 + (tid - 128);
        tok0 = 32 * (tid >> 6) + (tid & 31); }
    u32x4 pqv[2][4], pkv[2][4], pv[2], ps[2]; float pal[2], pmu[2], paL[2], gp[2], grs[2], ga[2], kb[2][2];
#define MLQ_LOAD(par, cn) do { const size_t adv = (size_t)(cn) * 64; \
        _Pragma("unroll") for (int i = 0; i < 4; ++i) { pqv[par][i] = *(const u32x4*)(qsrc + (adv + 16 * i) * 1024); pkv[par][i] = *(const u32x4*)(ksrc + (adv + 16 * i) * 1024); } \
        ps[par] = *(const u32x4*)(ssrc + (size_t)(cn) * 4096); pmu[par] = pbase[(cn) * 64 + 63]; paL[par] = gbase[(cn) * 64 + 63]; \
        if constexpr (ROLE != 2) { pv[par] = *(const u32x4*)(vsrc + adv * LDY0); pal[par] = alsrc[adv]; } \
        if constexpr (ROLE == 0) { gp[par] = pbase[adv + tok0]; grs[par] = rsbase[adv + tok0]; ga[par] = gbase[adv + tok0]; } \
        if constexpr (ROLE == 1) { kb[par][0] = kbsrc[(size_t)(cn) * 256]; kb[par][1] = kbsrc[(size_t)(cn) * 256 + 128]; } } while (0)
    MLQ_LOAD(0, 0); MLQ_LOAD(1, 1);
    f32x16 C2[2];
    if constexpr (ROLE == 2) {
#pragma unroll
        for (int k = 0; k < 2; ++k)
#pragma unroll
            for (int i = 0; i < 16; ++i) C2[k][i] = 0.f; }
    float mcar = 0.f;
    for (int ch2 = 0; ch2 < 64; ch2 += 2) {
#pragma unroll
      for (int par = 0; par < 2; ++par) { const int ch = ch2 + par;
        int tid = tid0; asm volatile("" : "+v"(tid));
        const int lane = tid & 63, r = lane & 31, hf = lane >> 5, prow = tid >> 5, pq = tid & 31, vrow = tid >> 3, vq = tid & 7;
        const float mu = pmu[par], aL = paL[par], mx = fmaxf(mcar, mu), decay = __expf(mcar - mx), delta = __expf(mu - mx);
#pragma unroll
        for (int i = 0; i < 4; ++i) { *(LAS u32x4*)(lds + MQ_Q + (prow + 16 * i) * 528 + pq * 16) = pqv[par][i]; *(LAS u32x4*)(lds + MQ_K + (prow + 16 * i) * 544 + pq * 16) = pkv[par][i]; }
        *(LAS u32x4*)(lds + MQ_S + vrow * 144 + vq * 16) = ps[par];
        if constexpr (ROLE != 2) { const float z = delta * pal[par]; const u32x4 pw = pv[par];
            { LAS u32x2* d8 = (LAS u32x2*)(lds + MQ_V + (tid >> 2) * 72 + (tid & 3) * 16); d8[0] = (u32x2){pw.x, pw.y}; d8[1] = (u32x2){pw.z, pw.w}; }
            u32x4 zv; zv.x = pg8::cvt_pk_bf16(lo16(pw.x) * z, hi16(pw.x) * z); zv.y = pg8::cvt_pk_bf16(lo16(pw.y) * z, hi16(pw.y) * z); zv.z = pg8::cvt_pk_bf16(lo16(pw.z) * z, hi16(pw.z) * z); zv.w = pg8::cvt_pk_bf16(lo16(pw.w) * z, hi16(pw.w) * z);
            { LAS u32x2* d8 = (LAS u32x2*)(lds + MQ_VZ + (tid >> 2) * 72 + (tid & 3) * 16); d8[0] = (u32x2){zv.x, zv.y}; d8[1] = (u32x2){zv.z, zv.w}; } }
        if constexpr (ROLE == 2) { if (ch > 0) {
            asm volatile("s_nop 15\n\ts_nop 7" : "+v"(C2[0]), "+v"(C2[1]));
#pragma unroll
            for (int k = 0; k < 2; ++k)
#pragma unroll
                for (int q4 = 0; q4 < 4; ++q4) { u32x2 o; o.x = pg8::cvt_pk_bf16(C2[k][4 * q4], C2[k][4 * q4 + 1]); o.y = pg8::cvt_pk_bf16(C2[k][4 * q4 + 2], C2[k][4 * q4 + 3]);
                    *(LAS u32x2*)(lds + MQ_C + r * 528 + (64 * (wave - 4) + 32 * k + 8 * q4 + 4 * hf) * 2) = o; } } }
        const float gpc = gp[par], grsc = grs[par], gac = ga[par], kbc0 = kb[par][0], kbc1 = kb[par][1];
        LDS_BARRIER();
        { const int cn = ch + 2 < 64 ? ch + 2 : 63; MLQ_LOAD(par, cn); }
        f32x16 cr, in; float et = 0.f, bt = 0.f, eexp = 0.f;
        if constexpr (ROLE == 0) {
            const int tt = wave;
#pragma unroll
            for (int i = 0; i < 16; ++i) { cr[i] = 0.f; in[i] = 0.f; }
            const LAS unsigned char* ca = lds + MQ_C + r * 528 + hf * 16; const LAS unsigned char* qa = lds + MQ_Q + (32 * tt + r) * 528 + hf * 16;
            const int il = lane & 15, g = lane >> 4;
            const LAS unsigned char* va = lds + MQ_V + (8 * (g >> 1) + (il >> 2)) * 72 + (16 * (g & 1) + 4 * (il & 3)) * 2;
            const LAS unsigned char* sa = lds + MQ_S + (32 * tt + r) * 144 + hf * 16;
            bf16x8 fc[2][4], fq[2][4], iv[4], is[4];
#pragma unroll
            for (int j = 0; j < 4; ++j) { fc[0][j] = *(const LAS bf16x8*)(ca + j * 32); fq[0][j] = *(const LAS bf16x8*)(qa + j * 32); }
#pragma unroll
            for (int gq = 0; gq < 4; ++gq) {
                if (gq < 3) {
#pragma unroll
                    for (int j = 0; j < 4; ++j) { const int ks = 4 * (gq + 1) + j; fc[(gq + 1) & 1][j] = *(const LAS bf16x8*)(ca + ks * 32); fq[(gq + 1) & 1][j] = *(const LAS bf16x8*)(qa + ks * 32); }
                } else {
#pragma unroll
                    for (int ks = 0; ks < 4; ++ks) { const s16x4 lo = lds_tr16(va + ks * 16 * 72), hi = lds_tr16(va + ks * 16 * 72 + 4 * 72);
                        iv[ks] = (bf16x8){lo[0], lo[1], lo[2], lo[3], hi[0], hi[1], hi[2], hi[3]}; is[ks] = *(const LAS bf16x8*)(sa + ks * 32); }
                }
#pragma unroll
                for (int j = 0; j < 4; ++j) cr = __builtin_amdgcn_mfma_f32_32x32x16_bf16(fc[gq & 1][j], fq[gq & 1][j], cr, 0, 0, 0);
                asm volatile("" : "+v"(cr) :: "memory");
            }
#pragma unroll
            for (int ks = 0; ks < 4; ++ks) in = __builtin_amdgcn_mfma_f32_32x32x16_bf16(iv[ks], is[ks], in, 0, 0, 0);
            const float Mt = fmaxf(mcar, gpc); et = __expf(mcar - Mt); bt = __expf(mu - Mt); eexp = __expf(-(gac + Mt));
        }
        if constexpr (ROLE == 1) {
            const int tt = wave - 2;
            f32x16 cn;
#pragma unroll
            for (int i = 0; i < 16; ++i) cn[i] = 0.f;
            const LAS unsigned char* qa = lds + MQ_Q + (32 * tt + r) * 528 + hf * 16; const LAS unsigned char* na = lds + MQ_NB + hf * 16;
            bf16x8 fq[2][4], fn[2][4];
#pragma unroll
            for (int j = 0; j < 4; ++j) { fq[0][j] = *(const LAS bf16x8*)(qa + j * 32); fn[0][j] = *(const LAS bf16x8*)(na + j * 32); }
#pragma unroll
            for (int gq = 0; gq < 4; ++gq) {
                if (gq < 3) {
#pragma unroll
                    for (int j = 0; j < 4; ++j) { const int ks = 4 * (gq + 1) + j; fq[(gq + 1) & 1][j] = *(const LAS bf16x8*)(qa + ks * 32); fn[(gq + 1) & 1][j] = *(const LAS bf16x8*)(na + ks * 32); }
                }
#pragma unroll
                for (int j = 0; j < 4; ++j) cn = __builtin_amdgcn_mfma_f32_32x32x16_bf16(fn[gq & 1][j], fq[gq & 1][j], cn, 0, 0, 0);
                asm volatile("" : "+v"(cn) :: "memory");
            }
            if (hf == 0) *(LAS float*)(lds + MQ_QN + (32 * tt + r) * 4) = cn[0];
        }
        if constexpr (ROLE == 2) {
            const int il = lane & 15, g = lane >> 4, d0 = 64 * (wave - 4);
#pragma unroll
            for (int k = 0; k < 2; ++k)
#pragma unroll
                for (int i = 0; i < 16; ++i) C2[k][i] *= decay;
            const LAS unsigned char* kbase = lds + MQ_K + (8 * (g >> 1) + (il >> 2)) * 544 + (d0 + 16 * (g & 1) + 4 * (il & 3)) * 2;
            const LAS unsigned char* vbase = lds + MQ_VZ + (8 * (g >> 1) + (il >> 2)) * 72 + (16 * (g & 1) + 4 * (il & 3)) * 2;
#pragma unroll
            for (int ks = 0; ks < 4; ++ks) {
                const s16x4 lo2 = lds_tr16(vbase + ks * 16 * 72), hi2 = lds_tr16(vbase + ks * 16 * 72 + 4 * 72); const bf16x8 vb = (bf16x8){lo2[0], lo2[1], lo2[2], lo2[3], hi2[0], hi2[1], hi2[2], hi2[3]};
#pragma unroll
                for (int k = 0; k < 2; ++k) { const s16x4 lo = lds_tr16(kbase + ks * 16 * 544 + k * 64), hi = lds_tr16(kbase + ks * 16 * 544 + 4 * 544 + k * 64);
                    C2[k] = __builtin_amdgcn_mfma_f32_32x32x16_bf16((bf16x8){lo[0], lo[1], lo[2], lo[3], hi[0], hi[1], hi[2], hi[3]}, vb, C2[k], 0, 0, 0); }
            }
        }
        LDS_BARRIER();
        {
            const int cf = ch > 0 ? ch - 1 : 0; const u32x4 ov = *(const LAS u32x4*)(lds + (par ? MQ_OUT : MQ_OUT2) + (tid >> 3) * 144 + (tid & 7) * 16);
            *(u32x4*)(HRAW + ((size_t)b * SEQ + cf * 64 + (tid >> 3)) * 1024 + h * 256 + es * 32 + (tid & 7) * 4) = ov; }
        if constexpr (ROLE == 0) {
            const int tt = wave; const float qn = *(const LAS float*)(lds + MQ_QN + (32 * tt + r) * 4);
            const float den = et * qn + bt * grsc, inv = 1.f / fmaxf(fabsf(den), eexp);
            LAS unsigned char* orow = lds + (par ? MQ_OUT2 : MQ_OUT) + (32 * tt + r) * 144 + 16 * hf;
#pragma unroll
            for (int q4 = 0; q4 < 4; ++q4) { f32x4 o; o.x = (et * cr[4 * q4] + bt * in[4 * q4]) * inv; o.y = (et * cr[4 * q4 + 1] + bt * in[4 * q4 + 1]) * inv; o.z = (et * cr[4 * q4 + 2] + bt * in[4 * q4 + 2]) * inv; o.w = (et * cr[4 * q4 + 3] + bt * in[4 * q4 + 3]) * inv;
                *(LAS f32x4*)(orow + 32 * q4) = o; } }
        if constexpr (ROLE == 1) { const int d = tid - 128; const float n0 = decay * nS[d] + delta * kbc0, n1 = decay * nS[d + 128] + delta * kbc1; nS[d] = n0; nS[d + 128] = n1;
            *(LAS unsigned short*)(lds + MQ_NB + d * 2) = (unsigned short)(pg8::cvt_pk_bf16(n0, n0) & 0xffffu); *(LAS unsigned short*)(lds + MQ_NB + (d + 128) * 2) = (unsigned short)(pg8::cvt_pk_bf16(n1, n1) & 0xffffu); }
        mcar = aL + mx;
      }
    }
    LDS_BARRIER();
    { const u32x4 ov = *(const LAS u32x4*)(lds + MQ_OUT2 + (tid0 >> 3) * 144 + (tid0 & 7) * 16); *(u32x4*)(HRAW + ((size_t)b * SEQ + 63 * 64 + (tid0 >> 3)) * 1024 + h * 256 + es * 32 + (tid0 & 7) * 4) = ov; }
#undef MLQ_LOAD
}
__device__ __forceinline__ void ph_ml_q(KArgs a, LAS unsigned char* lds, const Ctx& c) {
    unsigned char* ws = a.ws;
    const int tid0 = c.tid, wave = c.wave;
    LAS float* nS = (LAS float*)(lds + MQ_N);
    for (int u = blockIdx.x; u < 128; u += gridDim.x) {
        const int bh = (u & 7) * 2 + (u >> 6), es = (u >> 3) & 7, h = bh & 3, b = bh >> 2;
        __syncthreads();
        for (int i = tid0; i < 16896 / 4; i += NTHR) ((LAS unsigned*)(lds + MQ_C))[i] = 0u;
        if (tid0 < 256) nS[tid0] = 0.f;
        if (tid0 < 128) ((LAS unsigned*)(lds + MQ_NB))[tid0] = 0u;
        if (wave < 2) ml_q_loop<0>(lds, tid0, wave, ws, b, h, es, bh);
        else if (wave < 4) ml_q_loop<1>(lds, tid0, wave, ws, b, h, es, bh);
        else ml_q_loop<2>(lds, tid0, wave, ws, b, h, es, bh);
    }
}

__device__ __forceinline__ void ph_mlstm_post(KArgs a, const Ctx& c) {
    unsigned char* ws = a.ws; const bf16* Y0 = (const bf16*)(ws + WS_Y0); const float* HRAW = (const float*)(ws + WS_HRAW); bf16* MIXED = (bf16*)(ws + WS_MIXED);
    for (int m = c.gw; m < MTOK; m += c.ngw) {
        f32x4 v[4], g[4]; u32x2 ow[4];
#pragma unroll
        for (int h = 0; h < 4; ++h) { const int col = h * 256 + c.lane * 4; v[h] = *(const f32x4*)(HRAW + (size_t)m * 1024 + col); g[h] = *(const f32x4*)(a.in[I_MNORM] + col); ow[h] = *(const u32x2*)(Y0 + (size_t)m * LDY0 + YMO + col); }
#pragma unroll
        for (int h = 0; h < 4; ++h) { const int col = h * 256 + c.lane * 4;
            const float r = rsqrtf(wave_sum((v[h].x * v[h].x + v[h].y * v[h].y) + (v[h].z * v[h].z + v[h].w * v[h].w)) * (1.f / 256.f) + RMS_EPS);
            u32x2 o; o.x = pk2(v[h].x * r * g[h].x * sigmoidf_(lo16(ow[h].x)), v[h].y * r * g[h].y * sigmoidf_(hi16(ow[h].x))); o.y = pk2(v[h].z * r * g[h].z * sigmoidf_(lo16(ow[h].y)), v[h].w * r * g[h].w * sigmoidf_(hi16(ow[h].y)));
            *(u32x2*)(MIXED + (size_t)m * DM + 1024 + col) = o; }
    }
}

__device__ __forceinline__ void ph_ret_s(KArgs a, LAS unsigned char* lds, const Ctx& c) {
    unsigned char* ws = a.ws; const bf16* QR = (const bf16*)(ws + WS_Y1); const bf16* KR = (const bf16*)(ws + WS_Y1) + 2048; bf16* SR = (bf16*)(ws + WS_SR);
    const int lane = c.lane, wave = c.wave, r = lane & 31, hf = lane >> 5, sub = wave >> 2, st = (wave >> 1) & 1, tt = wave & 1;
    LAS unsigned char* qT = lds + sub * 67584; LAS unsigned char* kT = qT + 33792;
    for (int it = blockIdx.x; it < BATCH * RT_H * 32; it += gridDim.x) {
        const int u = 2 * it + sub, ch = u & 63, bh = u >> 6, h = bh & 7, b = bh >> 3; const size_t m0 = (size_t)b * SEQ + ch * 64;
        __syncthreads();
#pragma unroll
        for (int i = 0; i < 8; ++i) { const int idx = (c.tid & 255) + 256 * i, row = idx >> 5, q = idx & 31;
            *(LAS u32x4*)(qT + row * 528 + q * 16) = *(const u32x4*)(QR + (m0 + row) * LDY1 + h * 256 + q * 8);
            *(LAS u32x4*)(kT + row * 528 + q * 16) = *(const u32x4*)(KR + (m0 + row) * LDY1 + h * 256 + q * 8); }
        __syncthreads();
        f32x16 acc;
#pragma unroll
        for (int i = 0; i < 16; ++i) acc[i] = 0.f;
        if (tt >= st) {
            const LAS unsigned char* ka = kT + (32 * st + r) * 528 + hf * 16; const LAS unsigned char* qa = qT + (32 * tt + r) * 528 + hf * 16;
#pragma unroll
            for (int ks = 0; ks < 16; ++ks) acc = __builtin_amdgcn_mfma_f32_32x32x16_bf16(*(const LAS bf16x8*)(ka + ks * 32), *(const LAS bf16x8*)(qa + ks * 32), acc, 0, 0, 0);
        }
        const float l2g = log2f(1.f - exp2f(-5.f - (float)h)); const int t = 32 * tt + r;
        bf16* srow = SR + (size_t)u * 4096 + t * 64 + 32 * st + 4 * hf;
#pragma unroll
        for (int q4 = 0; q4 < 4; ++q4) { float v[4];
#pragma unroll
            for (int j = 0; j < 4; ++j) { const int s = 32 * st + 8 * q4 + 4 * hf + j; v[j] = t >= s ? acc[4 * q4 + j] * __builtin_amdgcn_exp2f((float)(t - s) * l2g) : 0.f; }
            u32x2 o; o.x = pg8::cvt_pk_bf16(v[0], v[1]); o.y = pg8::cvt_pk_bf16(v[2], v[3]); *(u32x2*)(srow + 8 * q4) = o; }
    }
}

constexpr int RQ_Q = 0, RQ_K = 33792, RQ_V = RQ_K + 64 * 544, RQ_VZ = RQ_V + 9216, RQ_S = RQ_VZ + 9216, RQ_R = RQ_S + 9216, RQ_END = RQ_R + 33792;
static_assert(RQ_END <= MISC_OFF, "retention LDS map");
template <bool CONS> __device__ __forceinline__ void ret_q_loop(LAS unsigned char* lds, int tid0, int wave, const bf16* Y1, const bf16* SR, bf16* YRET, int b, int h, int es, int bh) {
    asm volatile("" : "+v"(tid0));
    const float l2g = log2f(1.f - exp2f(-5.f - (float)h)), cd = __builtin_amdgcn_exp2f(64.f * l2g);
    const bf16* qsrc; const bf16* ksrc; const bf16* vsrc; const bf16* ssrc; float zeta;
    {
        const int tid = tid0, prow = tid >> 5, pq = tid & 31, vrow = (tid >> 3) & 31, vq = tid & 7;
        zeta = __builtin_amdgcn_exp2f((float)(63 - vrow) * l2g);
        qsrc = Y1 + ((size_t)b * SEQ + prow) * LDY1 + h * 256 + pq * 8; ksrc = qsrc + 2048;
        vsrc = Y1 + ((size_t)b * SEQ + vrow) * LDY1 + 4096 + h * 512 + es * 64 + vq * 8; ssrc = SR + ((size_t)bh * 64) * 4096 + vrow * 64 + vq * 8; }
    bf16* obase = YRET + ((size_t)b * SEQ) * 4096 + h * 512 + es * 64;
    const float zeta2 = zeta * __builtin_amdgcn_exp2f(-32.f * l2g);
    u32x4 pqv[2][4], pkv[2][4], pv[2][2], ps[2][2];
#pragma unroll
    for (int par = 0; par < 2; ++par) {
#pragma unroll
        for (int i = 0; i < 4; ++i) { pqv[par][i] = *(const u32x4*)(qsrc + (size_t)(64 * par + 16 * i) * LDY1); pkv[par][i] = *(const u32x4*)(ksrc + (size_t)(64 * par + 16 * i) * LDY1); }
        if constexpr (CONS) {
#pragma unroll
            for (int i = 0; i < 2; ++i) { pv[par][i] = *(const u32x4*)(vsrc + (size_t)(64 * par + 32 * i) * LDY1); ps[par][i] = *(const u32x4*)(ssrc + (size_t)par * 4096 + 32 * i * 64); } } }
    f32x16 R[4];
    if constexpr (!CONS) {
#pragma unroll
        for (int k = 0; k < 4; ++k)
#pragma unroll
            for (int i = 0; i < 16; ++i) R[k][i] = 0.f; }
    for (int ch2 = 0; ch2 < 64; ch2 += 2) {
#pragma unroll
      for (int par = 0; par < 2; ++par) { const int ch = ch2 + par;
        int tid = tid0; asm volatile("" : "+v"(tid));
        const int lane = tid & 63, r = lane & 31, hf = lane >> 5, prow = tid >> 5, pq = tid & 31, vrow = tid >> 3, vq = tid & 7;
#pragma unroll
        for (int i = 0; i < 4; ++i) { *(LAS u32x4*)(lds + RQ_Q + (prow + 16 * i) * 528 + pq * 16) = pqv[par][i]; *(LAS u32x4*)(lds + RQ_K + (prow + 16 * i) * 544 + pq * 16) = pkv[par][i]; }
        if constexpr (CONS) {
#pragma unroll
          for (int i2 = 0; i2 < 2; ++i2) { const int vr = (vrow & 31) + 32 * i2; const float zz = i2 ? zeta2 : zeta;
        *(LAS u32x4*)(lds + RQ_V + vr * 144 + vq * 16) = pv[par][i2]; *(LAS u32x4*)(lds + RQ_S + vr * 144 + vq * 16) = ps[par][i2];
        { const u32x4 pw = pv[par][i2]; u32x4 z; z.x = pg8::cvt_pk_bf16(lo16(pw.x) * zz, hi16(pw.x) * zz); z.y = pg8::cvt_pk_bf16(lo16(pw.y) * zz, hi16(pw.y) * zz); z.z = pg8::cvt_pk_bf16(lo16(pw.z) * zz, hi16(pw.z) * zz); z.w = pg8::cvt_pk_bf16(lo16(pw.w) * zz, hi16(pw.w) * zz);
          *(LAS u32x4*)(lds + RQ_VZ + vr * 144 + vq * 16) = z; } } }
        if constexpr (!CONS) { if (ch > 0) {
            asm volatile("s_nop 15\n\ts_nop 7" : "+v"(R[0]), "+v"(R[1]), "+v"(R[2]), "+v"(R[3]));
#pragma unroll
            for (int k = 0; k < 4; ++k) { const int dtl = k >> 1, et = k & 1;
#pragma unroll
                for (int q4 = 0; q4 < 4; ++q4) { u32x2 o; o.x = pg8::cvt_pk_bf16(R[k][4 * q4], R[k][4 * q4 + 1]); o.y = pg8::cvt_pk_bf16(R[k][4 * q4 + 2], R[k][4 * q4 + 3]);
                    *(LAS u32x2*)(lds + RQ_R + (32 * et + r) * 528 + (64 * (wave - 4) + 32 * dtl + 8 * q4 + 4 * hf) * 2) = o; } } } }
        LDS_BARRIER();
        {
            const int cn = ch + 2 < 64 ? ch + 2 : 63; const size_t adv = (size_t)cn * 64;
#pragma unroll
            for (int i = 0; i < 4; ++i) { pqv[par][i] = *(const u32x4*)(qsrc + (adv + 16 * i) * LDY1); pkv[par][i] = *(const u32x4*)(ksrc + (adv + 16 * i) * LDY1); }
            if constexpr (CONS) {
#pragma unroll
                for (int i = 0; i < 2; ++i) { pv[par][i] = *(const u32x4*)(vsrc + (adv + 32 * i) * LDY1); ps[par][i] = *(const u32x4*)(ssrc + (size_t)cn * 4096 + 32 * i * 64); } } }
        if constexpr (CONS) {
            const int et = wave >> 1, tt = wave & 1;
            f32x16 cr, in;
#pragma unroll
            for (int i = 0; i < 16; ++i) { cr[i] = 0.f; in[i] = 0.f; }
            const LAS unsigned char* ra = lds + RQ_R + (32 * et + r) * 528 + hf * 16; const LAS unsigned char* qa = lds + RQ_Q + (32 * tt + r) * 528 + hf * 16;
#pragma unroll
            for (int ks = 0; ks < 16; ++ks) { cr = __builtin_amdgcn_mfma_f32_32x32x16_bf16(*(const LAS bf16x8*)(ra + ks * 32), *(const LAS bf16x8*)(qa + ks * 32), cr, 0, 0, 0); if ((ks & 3) == 3) asm volatile("" : "+v"(cr) :: "memory"); }
            const int il = lane & 15, g = lane >> 4;
            const LAS unsigned char* va = lds + RQ_V + (8 * (g >> 1) + (il >> 2)) * 144 + (32 * et + 16 * (g & 1) + 4 * (il & 3)) * 2;
            const LAS unsigned char* sa = lds + RQ_S + (32 * tt + r) * 144 + hf * 16;
#pragma unroll
            for (int ks = 0; ks < 4; ++ks) { const s16x4 lo = lds_tr16(va + ks * 16 * 144), hi = lds_tr16(va + ks * 16 * 144 + 4 * 144);
                const bf16x8 av = (bf16x8){lo[0], lo[1], lo[2], lo[3], hi[0], hi[1], hi[2], hi[3]};
                in = __builtin_amdgcn_mfma_f32_32x32x16_bf16(av, *(const LAS bf16x8*)(sa + ks * 32), in, 0, 0, 0); }
            const float xi = __builtin_amdgcn_exp2f((float)(32 * tt + r + 1) * l2g);
            LAS unsigned char* orow = lds + RQ_OUT + (32 * tt + r) * 144 + (32 * et + 4 * hf) * 2;
#pragma unroll
            for (int q4 = 0; q4 < 4; ++q4) { u32x2 o; o.x = pg8::cvt_pk_bf16(in[4 * q4] + cr[4 * q4] * xi, in[4 * q4 + 1] + cr[4 * q4 + 1] * xi); o.y = pg8::cvt_pk_bf16(in[4 * q4 + 2] + cr[4 * q4 + 2] * xi, in[4 * q4 + 3] + cr[4 * q4 + 3] * xi);
                *(LAS u32x2*)(orow + 16 * q4) = o; }
        } else {
            const int il = lane & 15, g = lane >> 4, d0 = 64 * (wave - 4);
#pragma unroll
            for (int k = 0; k < 4; ++k)
#pragma unroll
                for (int i = 0; i < 16; ++i) R[k][i] *= cd;
            const LAS unsigned char* kbase = lds + RQ_K + (8 * (g >> 1) + (il >> 2)) * 544 + (d0 + 16 * (g & 1) + 4 * (il & 3)) * 2;
            const LAS unsigned char* vbase = lds + RQ_VZ + (8 * (g >> 1) + (il >> 2)) * 144 + (16 * (g & 1) + 4 * (il & 3)) * 2;
#pragma unroll
            for (int ks = 0; ks < 4; ++ks) {
                bf16x8 ka[2], vb[2];
#pragma unroll
                for (int x = 0; x < 2; ++x) { const s16x4 lo = lds_tr16(kbase + ks * 16 * 544 + x * 64), hi = lds_tr16(kbase + ks * 16 * 544 + 4 * 544 + x * 64); ka[x] = (bf16x8){lo[0], lo[1], lo[2], lo[3], hi[0], hi[1], hi[2], hi[3]};
                    const s16x4 lo2 = lds_tr16(vbase + ks * 16 * 144 + x * 64), hi2 = lds_tr16(vbase + ks * 16 * 144 + 4 * 144 + x * 64); vb[x] = (bf16x8){lo2[0], lo2[1], lo2[2], lo2[3], hi2[0], hi2[1], hi2[2], hi2[3]}; }
#pragma unroll
                for (int k = 0; k < 4; ++k) R[k] = __builtin_amdgcn_mfma_f32_32x32x16_bf16(ka[k >> 1], vb[k & 1], R[k], 0, 0, 0);
            }
        }
        LDS_BARRIER();
        { const u32x4 ov = *(const LAS u32x4*)(lds + RQ_OUT + (tid >> 3) * 144 + (tid & 7) * 16); *(u32x4*)(obase + ((size_t)(ch * 64 + (tid >> 3))) * 4096 + (tid & 7) * 8) = ov; }
      }
    }
}
__device__ __forceinline__ void ph_ret_q(KArgs a, LAS unsigned char* lds, const Ctx& c) {
    unsigned char* ws = a.ws; const bf16* Y1 = (const bf16*)(ws + WS_Y1); const bf16* SR = (const bf16*)(ws + WS_SR); bf16* YRET = (bf16*)(ws + WS_YRET);
    const int tid0 = c.tid, wave = c.wave;
    for (int u = blockIdx.x; u < 256; u += gridDim.x) {
        const int bh = (u & 7) * 4 + (u >> 6), es = (u >> 3) & 7, h = bh & 7, b = bh >> 3;
        __syncthreads();
        for (int i = tid0; i < 33792 / 4; i += NTHR) ((LAS unsigned*)(lds + RQ_R))[i] = 0u;
        if (wave < 4) ret_q_loop<true>(lds, tid0, wave, Y1, SR, YRET, b, h, es, bh);
        else ret_q_loop<false>(lds, tid0, wave, Y1, SR, YRET, b, h, es, bh);
    }
}

__device__ __forceinline__ void ph_ret_post(KArgs a, const Ctx& c) {
    unsigned char* ws = a.ws; const bf16* Y1 = (const bf16*)(ws + WS_Y1); bf16* YRET = (bf16*)(ws + WS_YRET);
    for (int m = c.gw; m < MTOK; m += c.ngw) {
        int ln = c.lane; asm volatile("" : "+v"(ln));
        u32x4 wv[8], gwv[8];
#pragma unroll
        for (int h = 0; h < 8; ++h) { const int col = h * 512 + ln * 8; wv[h] = *(const u32x4*)(YRET + (size_t)m * 4096 + col); gwv[h] = *(const u32x4*)(Y1 + (size_t)m * LDY1 + 8192 + col); }
#pragma unroll
        for (int h = 0; h < 8; ++h) { const int col = h * 512 + ln * 8; const u32x4 w = wv[h], gw = gwv[h];
            float v[8] = {lo16(w.x), hi16(w.x), lo16(w.y), hi16(w.y), lo16(w.z), hi16(w.z), lo16(w.w), hi16(w.w)};
            const float gg[8] = {lo16(gw.x), hi16(gw.x), lo16(gw.y), hi16(gw.y), lo16(gw.z), hi16(gw.z), lo16(gw.w), hi16(gw.w)};
            float ss = 0.f;
#pragma unroll
            for (int i = 0; i < 8; ++i) ss += v[i] * v[i];
            const float r = rsqrtf(wave_sum(ss) * (1.f / 512.f) + RMS_EPS);
            const f32x4 g0 = *(const f32x4*)(a.in[I_RNORM] + col), g1 = *(const f32x4*)(a.in[I_RNORM] + col + 4);
            const float gn[8] = {g0.x, g0.y, g0.z, g0.w, g1.x, g1.y, g1.z, g1.w};
#pragma unroll
            for (int i = 0; i < 8; ++i) v[i] = v[i] * r * gn[i] * siluf_(gg[i]);
            u32x4 o; o.x = pk2(v[0], v[1]); o.y = pk2(v[2], v[3]); o.z = pk2(v[4], v[5]); o.w = pk2(v[6], v[7]);
            *(u32x4*)(YRET + (size_t)m * 4096 + col) = o; }
    }
}

constexpr int MS_WGCNT = 768 * 1024;
__device__ __forceinline__ void ph_route(KArgs a, LAS unsigned char* lds, const Ctx& c) {
    unsigned char* ws = a.ws; const bf16* X3 = (const bf16*)(ws + WS_H); float* rstd = (float*)(ws + WS_MISC + MS_RSTD);
    int* toke = (int*)(ws + WS_MISC + MS_TOKE); float* tokg = (float*)(ws + WS_MISC + MS_TOKG); int* tokd = (int*)(ws + WS_MISC + MS_TOKD); unsigned* wgcnt = (unsigned*)(ws + WS_MISC + MS_WGCNT);
    const float* gain = a.in[I_NFO]; const float* wr = a.in[I_WR]; const int lane = c.lane;
    LAS unsigned* lcnt = (LAS unsigned*)lds;
    for (int w = blockIdx.x; w < MTOK / 64; w += gridDim.x) {
        __syncthreads();
        if (c.tid < 8) lcnt[c.tid] = 0u;
        __syncthreads();
#pragma unroll 1
        for (int k8 = 0; k8 < 8; ++k8) {
            const int m = w * 64 + c.wave * 8 + k8;
            const u32x4* xr = (const u32x4*)(X3 + (size_t)m * DM) + lane;
            u32x4 xv[4]; float s = 0.f;
#pragma unroll
            for (int j = 0; j < 4; ++j) { xv[j] = xr[64 * j]; const float e0 = lo16(xv[j].x), e1 = hi16(xv[j].x), e2 = lo16(xv[j].y), e3 = hi16(xv[j].y), e4 = lo16(xv[j].z), e5 = hi16(xv[j].z), e6 = lo16(xv[j].w), e7 = hi16(xv[j].w);
                s += ((e0 * e0 + e1 * e1) + (e2 * e2 + e3 * e3)) + ((e4 * e4 + e5 * e5) + (e6 * e6 + e7 * e7)); }
            const float r = rsqrtf(wave_sum(s) * (1.f / DM) + RMS_EPS);
            float lg[8];
#pragma unroll
            for (int e = 0; e < 8; ++e) lg[e] = 0.f;
#pragma unroll 2
            for (int j = 0; j < 4; ++j) { const int k0 = 8 * (64 * j + lane); const f32x4 ga = *(const f32x4*)(gain + k0), gb = *(const f32x4*)(gain + k0 + 4);
                const float y[8] = {lo16(xv[j].x) * r * ga.x, hi16(xv[j].x) * r * ga.y, lo16(xv[j].y) * r * ga.z, hi16(xv[j].y) * r * ga.w, lo16(xv[j].z) * r * gb.x, hi16(xv[j].z) * r * gb.y, lo16(xv[j].w) * r * gb.z, hi16(xv[j].w) * r * gb.w};
                const f32x4* w0 = (const f32x4*)(wr + (size_t)k0 * 8);
#pragma unroll
                for (int i = 0; i < 8; ++i) { const f32x4 wa = w0[2 * i], wb = w0[2 * i + 1];
                    lg[0] += y[i] * wa.x; lg[1] += y[i] * wa.y; lg[2] += y[i] * wa.z; lg[3] += y[i] * wa.w; lg[4] += y[i] * wb.x; lg[5] += y[i] * wb.y; lg[6] += y[i] * wb.z; lg[7] += y[i] * wb.w; } }
#pragma unroll
            for (int e = 0; e < 8; ++e) lg[e] = wave_sum(lg[e]);
            int i0 = 0; float v0 = lg[0];
#pragma unroll
            for (int e = 1; e < 8; ++e) if (lg[e] > v0) { v0 = lg[e]; i0 = e; }
            int i1 = -1; float v1 = -3.0e38f;
#pragma unroll
            for (int e = 0; e < 8; ++e) if (e != i0 && lg[e] > v1) { v1 = lg[e]; i1 = e; }
            if (lane == 0) { rstd[m] = r; const float g1 = 1.f / (1.f + __expf(v0 - v1)), g0 = 1.f - g1; toke[2 * m] = i0; toke[2 * m + 1] = i1; tokg[2 * m] = g0; tokg[2 * m + 1] = g1;
                tokd[2 * m] = (int)__hip_atomic_fetch_add(lcnt + i0, 1u, __ATOMIC_RELAXED, __HIP_MEMORY_SCOPE_WORKGROUP);
                tokd[2 * m + 1] = (int)__hip_atomic_fetch_add(lcnt + i1, 1u, __ATOMIC_RELAXED, __HIP_MEMORY_SCOPE_WORKGROUP); }
        }
        __syncthreads();
        if (c.tid < 8) wgcnt[w * 8 + c.tid] = lcnt[c.tid];
    }
}
__device__ __forceinline__ void ph_dispatch(KArgs a, LAS unsigned char* lds, const Ctx& c) {
    unsigned char* ws = a.ws; unsigned* ctl = (unsigned*)(ws + WS_CTL); const bf16* H = (const bf16*)(ws + WS_H); unsigned char* XBM = ws + WS_XBM;
    const int* toke = (const int*)(ws + WS_MISC + MS_TOKE); int* tokd = (int*)(ws + WS_MISC + MS_TOKD); const unsigned* wgcnt = (const unsigned*)(ws + WS_MISC + MS_WGCNT);
    LAS unsigned* tot = (LAS unsigned*)lds;
    __syncthreads();
    if (c.tid < 24) tot[c.tid] = 0u;
    __syncthreads();
    { const int e = c.tid & 7, part = c.tid >> 3; unsigned sacc = 0;
#pragma unroll
      for (int k = 0; k < 4; ++k) sacc += wgcnt[(part * 4 + k) * 8 + e];
      __hip_atomic_fetch_add(tot + e, sacc, __ATOMIC_RELAXED, __HIP_MEMORY_SCOPE_WORKGROUP); }
    __syncthreads();
    unsigned cnt[8], pst[8]; unsigned run = 0;
#pragma unroll
    for (int e = 0; e < 8; ++e) { cnt[e] = tot[e]; pst[e] = run; run += (cnt[e] + 255u) & ~255u; }
    if (c.gw == 0) {
        for (int pm = c.lane; pm < (int)(run >> 8); pm += 64) { unsigned e = 0;
#pragma unroll
            for (int q = 1; q < 8; ++q) if ((unsigned)pm * 256u >= pst[q]) e = q;
            ctl[CW_BLKE + pm] = e; }
        if (c.lane == 0) ctl[CW_NBLK] = run >> 8;
        if (c.lane < 8) { unsigned v = 0;
#pragma unroll
            for (int q = 0; q < 8; ++q) if (q == c.lane) v = pst[q] >> 8;
            ctl[CW_PST + c.lane] = v; }
    }
    for (int w = blockIdx.x; w < MTOK / 64; w += gridDim.x) {
        __syncthreads();
        if (c.tid < 8) tot[16 + c.tid] = 0u;
        __syncthreads();
        { const int e = c.tid & 7, part = c.tid >> 3; unsigned sacc = 0;
#pragma unroll
          for (int k = 0; k < 4; ++k) { const int ww = part * 4 + k; if (ww < w) sacc += wgcnt[ww * 8 + e]; }
          __hip_atomic_fetch_add(tot + 16 + e, sacc, __ATOMIC_RELAXED, __HIP_MEMORY_SCOPE_WORKGROUP); }
        __syncthreads();
#pragma unroll 1
        for (int k8 = 0; k8 < 8; ++k8) {
            const int m = w * 64 + c.wave * 8 + k8; const int e0 = toke[2 * m], e1 = toke[2 * m + 1];
            unsigned p0 = 0, p1 = 0;
#pragma unroll
            for (int q = 0; q < 8; ++q) { if (q == e0) p0 = pst[q]; if (q == e1) p1 = pst[q]; }
            const int d0 = (int)(p0 + tot[16 + e0]) + tokd[2 * m], d1 = (int)(p1 + tot[16 + e1]) + tokd[2 * m + 1];
            const u32x4* src = (const u32x4*)(H + (size_t)m * DM) + 4 * c.lane;
            const float rr = ((const float*)(ws + WS_MISC + MS_RSTD))[m]; unsigned w8[8];
#pragma unroll
            for (int j = 0; j < 4; ++j) { const u32x4 v = src[j]; w8[2 * j] = pk4_fp8(lo16(v.x) * rr, hi16(v.x) * rr, lo16(v.y) * rr, hi16(v.y) * rr); w8[2 * j + 1] = pk4_fp8(lo16(v.z) * rr, hi16(v.z) * rr, lo16(v.w) * rr, hi16(v.w) * rr); }
            { u32x4* q0 = (u32x4*)(XBM + (size_t)d0 * DM) + 2 * c.lane; u32x4* q1 = (u32x4*)(XBM + (size_t)d1 * DM) + 2 * c.lane; const u32x4 lo = (u32x4){w8[0], w8[1], w8[2], w8[3]}, hi = (u32x4){w8[4], w8[5], w8[6], w8[7]};
              q0[0] = lo; q0[1] = hi; q1[0] = lo; q1[1] = hi; }
            if (c.lane == 0) { tokd[2 * m] = d0; tokd[2 * m + 1] = d1; }
        }
    }
    for (int e = 0; e < 8; ++e) { const unsigned r0 = pst[e] + cnt[e], r1 = pst[e] + ((cnt[e] + 255u) & ~255u);
        for (unsigned r = r0 + c.gw; r < r1; r += c.ngw) {
            ((u32x4*)(XBM + (size_t)r * DM) + 2 * c.lane)[0] = (u32x4){0u, 0u, 0u, 0u}; ((u32x4*)(XBM + (size_t)r * DM) + 2 * c.lane)[1] = (u32x4){0u, 0u, 0u, 0u}; } }
}
__device__ __forceinline__ void ph_combine(KArgs a, const Ctx& c) {
    unsigned char* ws = a.ws; const bf16* YB = (const bf16*)(ws + WS_YB); const bf16* X3 = (const bf16*)(ws + WS_H); const float* tokg = (const float*)(ws + WS_MISC + MS_TOKG); const int* tokd = (const int*)(ws + WS_MISC + MS_TOKD);
    for (int m = c.gw; m < MTOK; m += c.ngw) {
        const int d0 = tokd[2 * m], d1 = tokd[2 * m + 1]; const float g0 = tokg[2 * m], g1 = tokg[2 * m + 1];
        const u32x4* x3 = (const u32x4*)(X3 + (size_t)m * DM) + c.lane; const u32x4* y0 = (const u32x4*)(YB + (size_t)d0 * DM) + c.lane; const u32x4* y1 = (const u32x4*)(YB + (size_t)d1 * DM) + c.lane;
        f32x4* xo = (f32x4*)(a.out + (size_t)m * DM) + c.lane * 2;
        u32x4 pp[4], qq[4], xx[4];
#pragma unroll
        for (int j = 0; j < 4; ++j) { pp[j] = y0[64 * j]; qq[j] = y1[64 * j]; xx[j] = x3[64 * j]; }
#pragma unroll
        for (int j = 0; j < 4; ++j) { const u32x4 p = pp[j], q = qq[j], x = xx[j]; f32x4 xa, xb;
            xa.x = lo16(x.x) + g0 * lo16(p.x) + g1 * lo16(q.x); xa.y = hi16(x.x) + g0 * hi16(p.x) + g1 * hi16(q.x); xa.z = lo16(x.y) + g0 * lo16(p.y) + g1 * lo16(q.y); xa.w = hi16(x.y) + g0 * hi16(p.y) + g1 * hi16(q.y);
            xb.x = lo16(x.z) + g0 * lo16(p.z) + g1 * lo16(q.z); xb.y = hi16(x.z) + g0 * hi16(p.z) + g1 * hi16(q.z); xb.z = lo16(x.w) + g0 * lo16(p.w) + g1 * lo16(q.w); xb.w = hi16(x.w) + g0 * hi16(p.w) + g1 * hi16(q.w);
            xo[128 * j] = xa; xo[128 * j + 1] = xb; }
    }
}


#define XB_TMO      128
#define XB_XCNT(j)  (256  + 64 * (j))
#define XB_XSUB(j)  (1280 + 64 * (j))
#define XB_XGEN(j)  (2304 + 64 * (j))
#define XB_TOP      3328
#define XB_TOPGEN   3392
#define XCD_BAR_WORDS 3456
#define XB_SPIN_CAP (1u << 18)
__device__ __forceinline__ unsigned xb_ld(unsigned* p)              { return __hip_atomic_load(p, __ATOMIC_RELAXED, __HIP_MEMORY_SCOPE_AGENT); }
__device__ __forceinline__ unsigned xb_add(unsigned* p, unsigned v) { return __hip_atomic_fetch_add(p, v, __ATOMIC_RELAXED, __HIP_MEMORY_SCOPE_AGENT); }
__device__ __forceinline__ unsigned xb_xcc_id() { return (unsigned)__builtin_amdgcn_s_getreg((3 << 11) | 20) & 0xFu; }
#define XB_SPIN(cond, bar) do { unsigned _sp = 0; while (cond) { __builtin_amdgcn_s_sleep(1); \
    if ((++_sp & 255u) == 0u) { if (xb_ld(&(bar)[XB_TMO])) break; if (_sp > XB_SPIN_CAP) { atomicAdd(&(bar)[XB_TMO], 1u); break; } } } } while (0)
struct XcdBarrier { unsigned* bar; unsigned x; volatile LAS unsigned* st; };
__device__ __forceinline__ XcdBarrier xcd_barrier_post(unsigned* bar, volatile LAS unsigned* st) {
    XcdBarrier b; b.bar = bar; b.x = xb_xcc_id(); b.st = st;
    if (threadIdx.x == 0) (void)xb_add(&bar[XB_XCNT(b.x)], 1u);
    return b;
}
__device__ __forceinline__ void xcd_barrier_complete(unsigned* bar, unsigned x, unsigned& nloc, unsigned& nx) {
    const unsigned G = gridDim.x * gridDim.y * gridDim.z;
    unsigned sum, cnt, mine, sp = 0u;
    for (;;) {
        sum = 0u; cnt = 0u; mine = 0u;
#pragma unroll
        for (unsigned j = 0; j < 16; ++j) { const unsigned c = xb_ld(&bar[XB_XCNT(j)]); sum += c; cnt += (c > 0u) ? 1u : 0u; mine = (j == x) ? c : mine; }
        if (sum == G) break;
        __builtin_amdgcn_s_sleep(1);
        if ((++sp & 255u) == 0u) { if (xb_ld(&bar[XB_TMO])) break; if (sp > XB_SPIN_CAP) { atomicAdd(&bar[XB_TMO], 1u); break; } }
    }
    nloc = mine > 0u ? mine : 1u; nx = cnt > 0u ? cnt : 1u;
}
__device__ __forceinline__ void xcd_barrier(const XcdBarrier& b) {
    asm volatile("s_waitcnt vmcnt(0)" ::: "memory");
    __syncthreads();
    if (threadIdx.x == 0) {
        unsigned* bar = b.bar;
        __builtin_amdgcn_s_waitcnt(0);
        unsigned nloc = b.st[0], nx = b.st[1];
        if (nloc == 0u) { xcd_barrier_complete(bar, b.x, nloc, nx); b.st[0] = nloc; b.st[1] = nx; }
        const unsigned old = xb_add(&bar[XB_XSUB(b.x)], 1u);
        const unsigned gen = old / nloc;
        if (old + 1u == (gen + 1u) * nloc) {
            __builtin_amdgcn_fence(__ATOMIC_RELEASE, "agent");
            asm volatile("s_waitcnt vmcnt(0)" ::: "memory");
            const unsigned og = xb_add(&bar[XB_TOP], 1u);
            const unsigned tg = og / nx;
            if (og + 1u == (tg + 1u) * nx) xb_add(&bar[XB_TOPGEN], 1u);
            else XB_SPIN(xb_ld(&bar[XB_TOPGEN]) == tg, bar);
            __builtin_amdgcn_fence(__ATOMIC_ACQUIRE, "agent");
            xb_add(&bar[XB_XGEN(b.x)], 1u);
            asm volatile("s_waitcnt vmcnt(0)" ::: "memory");
        } else {
            XB_SPIN(xb_ld(&bar[XB_XGEN(b.x)]) == gen, bar);
            __builtin_amdgcn_fence(__ATOMIC_ACQUIRE, "agent");
            asm volatile("s_waitcnt vmcnt(0)" ::: "memory");
        }
    }
    __syncthreads();
}

enum { P_PRO = 0, P_G1, P_PREP0, P_MLS, P_MIX, P_MLP, P_G2, P_G3, P_G4, P_G5, P_RS, P_RQ, P_RP, P_G6, P_ROUTE, P_DISP, P_G7, P_G8, P_COMB, P_END };

template <int PH> __device__ __forceinline__ void run_phase(LAS unsigned char* lds) {
    KArgs a = get_args(); unsigned char* ws = a.ws; const int G = gridDim.x, bx = blockIdx.x;
#define MK_CTX(cn) Ctx cn; { int t_ = threadIdx.x; asm volatile("" : "+v"(t_)); cn.tid = t_; } cn.lane = cn.tid & 63; cn.wave = __builtin_amdgcn_readfirstlane(cn.tid >> 6); cn.gw = bx * NWAVES + cn.wave; cn.ngw = G * NWAVES
    MK_CTX(c);
    if constexpr (PH == P_PRO) ph_prologue(a, lds, c);
    if constexpr (PH == P_G1) { pg8::Gemm g{(const bf16*)(ws + WS_H), (const bf16*)(ws + WS_WIE), DM, (const float*)(ws + WS_RSS)}; pg8::PanelOrder S; S.init(MTOK / 256, LDY0 / 256, G, bx);
        pg8::EpiBf16RS E{(bf16*)(ws + WS_Y0), LDY0}; pg8::gemm_phase<false>(lds, g, S, E); }
    if constexpr (PH == P_PREP0) { ph_compress(a, lds, c); MK_CTX(c2); ph_vtrans(a, lds, c2); MK_CTX(c3); ph_prep0(a, c3); }
    if constexpr (PH == P_MLS) ph_ml_s(a, lds, c);
    if constexpr (PH == P_MIX) { ph_ml_q(a, lds, c); MK_CTX(c2); ph_nsa(a, lds, c2); }
    if constexpr (PH == P_MLP) ph_mlstm_post(a, c);
    if constexpr (PH == P_G2) { pg8::Gemm g{(const bf16*)(ws + WS_MIXED), (const bf16*)(ws + WS_WOE), DM, nullptr}; pg8::StaticOrder S; S.init(MTOK / 256, DM / 256, G, bx);
        pg8::EpiResB16<true> E{(const bf16*)(ws + WS_H), (bf16*)(ws + WS_XB), DM, (float*)(ws + WS_RSS)}; pg8::gemm_phase<false>(lds, g, S, E); }
    if constexpr (PH == P_G3) { pg8::Gemm g{(const bf16*)(ws + WS_XB), (const bf16*)(ws + WS_WGU), DM, (const float*)(ws + WS_RSS)}; pg8::PanelOrder S; S.init(MTOK / 256, 2 * FFN / 256, G, bx);
        pg8::EpiSwigluRS E{(bf16*)(ws + WS_ACT), FFN}; pg8::gemm_phase<false>(lds, g, S, E); }
    if constexpr (PH == P_G4) { pg8::Gemm g{(const bf16*)(ws + WS_ACT), (const bf16*)(ws + WS_WD), FFN, nullptr}; pg8::StaticOrder S; S.init(MTOK / 256, DM / 256, G, bx);
        pg8::EpiResB16<true> E{(const bf16*)(ws + WS_XB), (bf16*)(ws + WS_XB + 64 * MiB), DM, (float*)(ws + WS_RSS)}; pg8::gemm_phase<false>(lds, g, S, E); }
    if constexpr (PH == P_G5) { pg8::Gemm g{(const bf16*)(ws + WS_XB + 64 * MiB), (const bf16*)(ws + WS_WIO), DM, (const float*)(ws + WS_RSS)}; pg8::PanelOrder S; S.init(MTOK / 256, LDY1 / 256, G, bx);
        pg8::EpiBf16RopeRS E{(bf16*)(ws + WS_Y1), LDY1, (const int*)a.in[I_POS]}; pg8::gemm_phase<false>(lds, g, S, E); }
    if constexpr (PH == P_RS) ph_ret_s(a, lds, c);
    if constexpr (PH == P_RQ) ph_ret_q(a, lds, c);
    if constexpr (PH == P_RP) ph_ret_post(a, c);
    if constexpr (PH == P_G6) { pg8::Gemm g{(const bf16*)(ws + WS_YRET), (const bf16*)(ws + WS_WOO), 2 * DM, nullptr}; pg8::StaticOrder S; S.init(MTOK / 256, DM / 256, G, bx);
        pg8::EpiResB16<false> E{(const bf16*)(ws + WS_XB + 64 * MiB), (bf16*)(ws + WS_H), DM, nullptr}; pg8::gemm_phase<false>(lds, g, S, E); }
    if constexpr (PH == P_ROUTE) ph_route(a, lds, c);
    if constexpr (PH == P_DISP) ph_dispatch(a, lds, c);
    if constexpr (PH == P_G7) { const unsigned* ctl = (const unsigned*)(ws + WS_CTL); const int nblk = (int)__hip_atomic_load(ctl + CW_NBLK, __ATOMIC_RELAXED, __HIP_MEMORY_SCOPE_AGENT);
        pg8::Gemm g{ws + WS_XBM, ws + WS_EGU, DM, nullptr}; pg8::MoeOrder S; S.init(nblk, 2 * FFN / 256, G, bx); S.load(ctl + CW_PST); S.estride = (size_t)2 * FFN * DM;
        pg8::EpiSwigluF8 E{ws + WS_ACTE, FFN, 1.f / 64.f, 4.f}; pg8::gemm_phase<true>(lds, g, S, E); }
    if constexpr (PH == P_G8) { const unsigned* ctl = (const unsigned*)(ws + WS_CTL); const int nblk = (int)__hip_atomic_load(ctl + CW_NBLK, __ATOMIC_RELAXED, __HIP_MEMORY_SCOPE_AGENT);
        pg8::Gemm g{ws + WS_ACTE, ws + WS_ED, FFN, nullptr}; pg8::MoeOrder S; S.init(nblk, DM / 256, G, bx); S.load(ctl + CW_PST); S.estride = (size_t)FFN * DM;
        pg8::EpiBf16 E{(bf16*)(ws + WS_YB), DM, 1.f / 256.f}; pg8::gemm_phase<true>(lds, g, S, E); }
    if constexpr (PH == P_COMB) ph_combine(a, c);
}

template <int PH> __global__ void __launch_bounds__(NTHR, 2) k_phase(Args a) {
    extern __shared__ __attribute__((aligned(16))) unsigned char lds_raw[];
    LAS unsigned char* lds = (LAS unsigned char*)lds_raw;
    run_phase<PH>(lds);
}

template <int PH> __device__ __forceinline__ void run_from(LAS unsigned char* lds, const XcdBarrier& bar) {
    if constexpr (PH < P_END) {
        run_phase<PH>(lds);
#if defined(PROBE_DUP)
        if constexpr (((PROBE_DUP) >> PH) & 1ull) { xcd_barrier(bar); run_phase<PH>(lds); }
#endif
        if constexpr (PH + 1 < P_END) xcd_barrier(bar);
        run_from<PH + 1>(lds, bar);
    }
}
__global__ void __launch_bounds__(NTHR, 2) k_all(Args a) {
    extern __shared__ __attribute__((aligned(16))) unsigned char lds_raw[];
    LAS unsigned char* lds = (LAS unsigned char*)lds_raw;
    volatile LAS unsigned* misc = (volatile LAS unsigned*)(lds + MISC_OFF);
    if (threadIdx.x < 4) misc[threadIdx.x] = 0u;
    __syncthreads();
    const XcdBarrier bar = xcd_barrier_post((unsigned*)(get_args().ws + WS_CTL) + CW_BAR, misc);
    run_from<0>(lds, bar);
}

template <int PH> static void launch_phase(const Args& a, int grid, hipStream_t stream) {
    static bool attr = false;
    if (!attr) { (void)hipFuncSetAttribute((const void*)k_phase<PH>, hipFuncAttributeMaxDynamicSharedMemorySize, LDS_BYTES); attr = true; }
    hipLaunchKernelGGL(k_phase<PH>, dim3(grid), dim3(NTHR), LDS_BYTES, stream, a);
}
template <int PH> static void launch_all(const Args& a, int grid, hipStream_t stream) {
    if constexpr (PH < P_END) { launch_phase<PH>(a, grid, stream); launch_all<PH + 1>(a, grid, stream); }
}

extern "C" void kernel_launch(void* const* d_in, const int* in_sizes, int n_in, void* d_out, int out_size, void* d_ws, size_t ws_size, hipStream_t stream) {
    if (n_in != 26 || ws_size < WS_NEED) { fprintf(stderr, "kernel_launch: unexpected inputs (n_in %d, ws %zu, need %zu)\n", n_in, ws_size, (size_t)WS_NEED); return; }
    (void)hipMemsetAsync((char*)d_ws + WS_CTL, 0, CTL_ZERO_BYTES, stream);
    Args a{};
    for (int i = 0; i < 26; ++i) a.in[i] = (const float*)d_in[i];
    a.out = (float*)d_out; a.ws = (unsigned char*)d_ws; a.ph_lo = 0; a.ph_hi = P_END;
#if defined(MK_MULTI)
    launch_all<0>(a, 256, stream);
#else
    static bool attr = false;
    if (!attr) { (void)hipFuncSetAttribute((const void*)k_all, hipFuncAttributeMaxDynamicSharedMemorySize, LDS_BYTES); attr = true; }
    hipLaunchKernelGGL(k_all, dim3(256), dim3(NTHR), LDS_BYTES, stream, a);
#endif
}
```

```cpp
#include <hip/hip_runtime.h>
#include <cstdio>
#include <cstdint>

#define LAS __attribute__((address_space(3)))
typedef unsigned short bf16;
typedef short bf16x8 __attribute__((ext_vector_type(8)));
typedef float f32x4 __attribute__((ext_vector_type(4)));
typedef float f32x2 __attribute__((ext_vector_type(2)));
typedef unsigned u32x4 __attribute__((ext_vector_type(4)));
typedef unsigned u32x2 __attribute__((ext_vector_type(2)));

constexpr int BATCH = 4, SEQ = 4096, DM = 2048, MTOK = BATCH * SEQ;
constexpr int HD = 128, NSA_H = 8, NSA_G = 2, NC = 255, NSB = 64;
constexpr int ML_H = 4, ML_D = 256;
constexpr int RT_H = 8, RT_DK = 256, RT_DV = 512;
constexpr int FFN = 5632, NEXP = 8;
constexpr int EVEN_IN = 6688, ODD_IN = 12288;
constexpr float RMS_EPS = 1e-6f;
constexpr int LDY0 = 6912, YQ = 0, YKC = 1024, YVC = 1280, YKS = 1536, YVS = 1792, YKW = 2048, YVW = 2304, YMQ = 2560, YMK = 3584, YMV = 4608, YMO = 5632, YG = 6656, YI = 6680, YF = 6684;
constexpr int LDY1 = 12288;
constexpr int MOE_ROWS = 2 * MTOK + NEXP * 256;

constexpr size_t MiB = 1u << 20;
constexpr size_t WS_CTL = 0, CTL_ZERO_BYTES = 1 * MiB;
constexpr size_t WS_WIE = 2 * MiB, WS_WOE = 29 * MiB, WS_WGU = 37 * MiB, WS_WD = 81 * MiB, WS_WIO = 103 * MiB, WS_WOO = 151 * MiB, WS_EGU = 167 * MiB, WS_ED = 519 * MiB;
constexpr size_t WS_WCK = 695 * MiB, WS_WCV = 696 * MiB, WS_MISC = 697 * MiB, WS_H = 698 * MiB, WS_XB = 762 * MiB, WS_R = 890 * MiB;
constexpr size_t WS_Y0 = WS_R, WS_ACT = WS_R, WS_QN = WS_R + 216 * MiB, WS_KSN = WS_QN + 32 * MiB, WS_KWN = WS_KSN + 8 * MiB, WS_MQ = WS_KWN + 8 * MiB, WS_MK = WS_MQ + 32 * MiB,
                 WS_KCN = WS_MK + 32 * MiB, WS_VCC = WS_KCN + 1 * MiB, WS_SB = WS_VCC + 1 * MiB, WS_HRAW = WS_SB + 16 * MiB, WS_MIXED = WS_HRAW + 64 * MiB, WS_VST = WS_MIXED + 64 * MiB, WS_VWT = WS_VST + 8 * MiB, WS_VCT = WS_VWT + 8 * MiB, WS_L0END = WS_VCT + 1 * MiB;
constexpr size_t WS_Y1 = WS_R, WS_YRET = WS_R + 384 * MiB, WS_QR = 2 * MiB, WS_SR = 66 * MiB, WS_KR = WS_H;
constexpr size_t WS_XBM = WS_R, WS_ACTE = WS_R + 136 * MiB, WS_YB = 2 * MiB;
constexpr size_t WS_RSS = WS_R + 512 * MiB;
constexpr size_t WS_NEED = WS_RSS + 2 * MiB;
static_assert(WS_L0END <= WS_NEED && WS_ACTE + (size_t)MOE_ROWS * FFN * 2 <= WS_NEED, "ws map");
constexpr size_t MS_TOKE = 0, MS_TOKG = 128 * 1024, MS_TOKD = 256 * 1024, MS_RSTD = 384 * 1024, MS_PEW = 512 * 1024;
constexpr int CW_CNT = 64, CW_CUR = 128, CW_PST = 192, CW_NBLK = 320, CW_BLKE = 384, CW_NSAQ = 1024, CW_BAR = 4096;

__device__ __forceinline__ float bf2f(unsigned b) { return __uint_as_float(b << 16); }
__device__ __forceinline__ unsigned f2bf(float f) { unsigned u = __float_as_uint(f); return (u + 0x7fffu + ((u >> 16) & 1u)) >> 16; }
__device__ __forceinline__ unsigned pk2(float lo, float hi) { return f2bf(lo) | (f2bf(hi) << 16); }
__device__ __forceinline__ unsigned pk4_fp8(float a, float b, float c2, float d) {
    a = fminf(fmaxf(a, -440.f), 440.f); b = fminf(fmaxf(b, -440.f), 440.f); c2 = fminf(fmaxf(c2, -440.f), 440.f); d = fminf(fmaxf(d, -440.f), 440.f);
    int p = __builtin_amdgcn_cvt_pk_fp8_f32(a, b, 0, false); p = __builtin_amdgcn_cvt_pk_fp8_f32(c2, d, p, true); return (unsigned)p; }
__device__ __forceinline__ float lo16(unsigned w) { return __uint_as_float(w << 16); }
__device__ __forceinline__ float hi16(unsigned w) { return __uint_as_float(w & 0xffff0000u); }
__device__ __forceinline__ float wave_sum(float v) {
#pragma unroll
    for (int o = 1; o < 64; o <<= 1) v += __shfl_xor(v, o);
    return v;
}
__device__ __forceinline__ float wave_max(float v) {
#pragma unroll
    for (int o = 1; o < 64; o <<= 1) v = fmaxf(v, __shfl_xor(v, o));
    return v;
}
__device__ __forceinline__ float sigmoidf_(float x) { return 1.f / (1.f + __expf(-x)); }
__device__ __forceinline__ float siluf_(float x) { return x / (1.f + __expf(-x)); }
#define LDS_WAIT() asm volatile("s_waitcnt lgkmcnt(0)" ::: "memory")
#define VM_WAIT() asm volatile("s_waitcnt vmcnt(0)" ::: "memory")
#define LDS_BARRIER() do { asm volatile("s_waitcnt lgkmcnt(0)" ::: "memory"); __builtin_amdgcn_s_barrier(); asm volatile("" ::: "memory"); } while (0)

struct Args { const float* in[26]; float* out; unsigned char* ws; int ph_lo, ph_hi; };
typedef const __attribute__((address_space(4))) Args& KArgs;
__device__ __forceinline__ KArgs get_args() { const __attribute__((address_space(4))) Args* p = (const __attribute__((address_space(4))) Args*)__builtin_amdgcn_kernarg_segment_ptr(); asm volatile("" : "+s"(p)); return *p; }
enum { I_X = 0, I_POS, I_NME, I_WIE, I_QG, I_KG, I_WCK, I_WCV, I_PE, I_CONV, I_FB, I_MNORM, I_WOE, I_NFE, I_FG, I_FU, I_FD, I_NMO, I_WIO, I_RNORM, I_WOO, I_NFO, I_WR, I_EG, I_EU, I_ED };

namespace pg8 {
#define PG8_LAS __attribute__((address_space(3)))
typedef unsigned short bf16_t;
constexpr int BM = 256, BK = 64, HALF = 128, HTB = HALF * BK * 2, STAGE_BYTES = 8 * HTB, NXCD = 8, WGM = 8;
__host__ __device__ __forceinline__ int lds_byte(int r, int c) { const int st = (r >> 4) * 2 + (c >> 5), rr = r & 15, cc = c & 31, ob = rr * 64 + cc * 2; return st * 1024 + (ob ^ (((ob >> 9) & 1) << 5)); }
__host__ __device__ __forceinline__ void stage_rc(int b, int& R, int& C) { const int st = b / 1024, sb = b % 1024, swz = sb ^ (((sb >> 9) & 1) << 5); R = (st >> 1) * 16 + swz / 64; C = (st & 1) * 32 + (swz % 64) / 2; }
__host__ __device__ __forceinline__ int perm32(int rho) { const int n = rho >> 4, i = rho & 15; return 8 * (i >> 2) + 4 * n + (i & 3); }
struct Unit { int pm, pn; };
struct Gemm { const void* A; const void* Bt; int K; const float* rss; };
typedef int v8i32 __attribute__((ext_vector_type(8)));
typedef int v4i32 __attribute__((ext_vector_type(4)));
struct StaticOrder {
    int nM, nN, nwg, G, c;
    __device__ void init(int nM_, int nN_, int G_, int c_) { nM = nM_; nN = nN_; nwg = nM * nN; G = G_; c = c_; }
    __device__ bool next(int i, Unit& u) const {
        const long L = (long)i * G + c; if (L >= nwg) return false;
        int wgid = (int)L; { const int q = nwg / NXCD, r = nwg % NXCD, xcd = wgid % NXCD, off = wgid / NXCD; wgid = (xcd < r ? xcd * (q + 1) : r * (q + 1) + (xcd - r) * q) + off; }
        const int nig = WGM * nN, gid = wgid / nig, fm = gid * WGM, gsz = (nM - fm) < WGM ? (nM - fm) : WGM;
        u.pm = fm + ((wgid % nig) % gsz); u.pn = (wgid % nig) / gsz; return true;
    }
    __device__ __forceinline__ size_t boff(const Unit&) const { return 0; }
};
struct PanelOrder {
    int nN, G, c;
    __device__ void init(int, int nN_, int G_, int c_) { nN = nN_; G = G_; c = c_; }
    __device__ bool next(int i, Unit& u) const {
        if (G != 256) { const long L = (long)i * G + c; if (L >= 64L * nN) return false; u.pm = (int)(L / nN); u.pn = (int)(L % nN); return true; }
        const int xcd = c & 7, idx = c >> 3; u.pm = xcd * 8 + (idx >> 2); u.pn = (idx & 3) + 4 * i; return u.pn < nN;
    }
    __device__ __forceinline__ size_t boff(const Unit&) const { return 0; }
};
struct MoeOrder : StaticOrder {
    int pb[8]; size_t estride;
    __device__ __forceinline__ void load(const unsigned* pbt) {
#pragma unroll
        for (int q = 0; q < 8; ++q) pb[q] = __builtin_amdgcn_readfirstlane((int)__hip_atomic_load(pbt + q, __ATOMIC_RELAXED, __HIP_MEMORY_SCOPE_AGENT)); }
    __device__ __forceinline__ size_t boff(const Unit& u) const { int e = 0;
#pragma unroll
        for (int q = 1; q < 8; ++q) e += (u.pm >= pb[q]) ? 1 : 0;
        return (size_t)e * estride; }
};
__device__ __forceinline__ unsigned cvt_pk_bf16(float lo, float hi) { unsigned r; asm volatile("v_cvt_pk_bf16_f32 %0, %1, %2" : "=v"(r) : "v"(lo), "v"(hi)); return r; }

struct EpiBf16 {
    static constexpr bool PERM = true, ROWSCALE = false;
    bf16_t* O; int ldc; float sc;
    __device__ __forceinline__ void operator()(const f32x4 (&acc)[2][2][4][2], const Unit& u, int wr, int wc, int fr, int fq, const PG8_LAS float*) const {
        const int row0 = u.pm * BM + wr * 64 + fr, col0 = u.pn * BM + wc * 32 + 8 * fq;
#pragma unroll
        for (int ai = 0; ai < 2; ++ai)
#pragma unroll
            for (int m = 0; m < 4; ++m) { bf16_t* rowp = O + (size_t)(row0 + ai * HALF + m * 16) * ldc + col0;
#pragma unroll
                for (int bj = 0; bj < 2; ++bj) { const f32x4 v0 = acc[ai][bj][m][0] * sc, v1 = acc[ai][bj][m][1] * sc;
                    u32x4 w; w.x = cvt_pk_bf16(v0[0], v0[1]); w.y = cvt_pk_bf16(v0[2], v0[3]); w.z = cvt_pk_bf16(v1[0], v1[1]); w.w = cvt_pk_bf16(v1[2], v1[3]);
                    *(u32x4*)(rowp + bj * HALF) = w; } }
    }
};
struct EpiSwigluF8 {
    static constexpr bool PERM = true, ROWSCALE = false;
    unsigned char* O; int ldc; float iscale, oscale;
    __device__ __forceinline__ void operator()(const f32x4 (&acc)[2][2][4][2], const Unit& u, int wr, int wc, int fr, int fq, const PG8_LAS float*) const {
        const int row0 = u.pm * BM + wr * 64 + fr, col0 = u.pn * HALF + wc * 32 + 8 * fq;
        const float k1 = -1.4426950408889634f * iscale, ik2 = 1.f / (iscale * iscale * oscale);
#pragma unroll
        for (int ai = 0; ai < 2; ++ai)
#pragma unroll
            for (int m = 0; m < 4; ++m) { float o[8];
#pragma unroll
                for (int n = 0; n < 2; ++n)
#pragma unroll
                    for (int j = 0; j < 4; ++j) { const float ag = acc[ai][0][m][n][j], au = acc[ai][1][m][n][j], e = __builtin_amdgcn_exp2f(ag * k1); o[n * 4 + j] = (ag * au) * __builtin_amdgcn_rcpf(fmaf(e, ik2, ik2)); }
                u32x2 w; w.x = pk4_fp8(o[0], o[1], o[2], o[3]); w.y = pk4_fp8(o[4], o[5], o[6], o[7]);
                *(u32x2*)(O + (size_t)(row0 + ai * HALF + m * 16) * ldc + col0) = w; }
    }
};
constexpr int RS_LDS_OFF = 131072;
template <bool RSSW> struct EpiResB16 {
    static constexpr bool PERM = true, ROWSCALE = false;
    const bf16_t* base; bf16_t* out; int ldc; float* rss;
    __device__ __forceinline__ void operator()(const f32x4 (&acc)[2][2][4][2], const Unit& u, int wr, int wc, int fr, int fq, const PG8_LAS float*) const {
        const int row0 = u.pm * BM + wr * 64 + fr, col0 = u.pn * BM + wc * 32 + 8 * fq;
#pragma unroll
        for (int ai = 0; ai < 2; ++ai)
#pragma unroll
            for (int m = 0; m < 4; ++m) { const int row = row0 + ai * HALF + m * 16; const size_t off = (size_t)row * ldc + col0; float ss = 0.f;
#pragma unroll
                for (int bj = 0; bj < 2; ++bj) { const u32x4 bs = *(const u32x4*)(base + off + bj * HALF); const f32x4 a0 = acc[ai][bj][m][0], a1 = acc[ai][bj][m][1];
                    const float x0 = lo16(bs.x) + a0[0], x1 = hi16(bs.x) + a0[1], x2 = lo16(bs.y) + a0[2], x3 = hi16(bs.y) + a0[3], x4 = lo16(bs.z) + a1[0], x5 = hi16(bs.z) + a1[1], x6 = lo16(bs.w) + a1[2], x7 = hi16(bs.w) + a1[3];
                    ss += ((x0 * x0 + x1 * x1) + (x2 * x2 + x3 * x3)) + ((x4 * x4 + x5 * x5) + (x6 * x6 + x7 * x7));
                    u32x4 w; w.x = cvt_pk_bf16(x0, x1); w.y = cvt_pk_bf16(x2, x3); w.z = cvt_pk_bf16(x4, x5); w.w = cvt_pk_bf16(x6, x7); *(u32x4*)(out + off + bj * HALF) = w; }
                if (RSSW) { ss += __shfl_xor(ss, 16); ss += __shfl_xor(ss, 32); if (fq == 0) rss[(size_t)row * 32 + u.pn * 4 + wc] = ss; } }
    }
};
struct EpiBf16RS {
    static constexpr bool PERM = true, ROWSCALE = true;
    bf16_t* O; int ldc;
    __device__ __forceinline__ void operator()(const f32x4 (&acc)[2][2][4][2], const Unit& u, int wr, int wc, int fr, int fq, const PG8_LAS float* rs) const {
        const int rl0 = wr * 64 + fr, col0 = u.pn * BM + wc * 32 + 8 * fq;
#pragma unroll
        for (int ai = 0; ai < 2; ++ai)
#pragma unroll
            for (int m = 0; m < 4; ++m) { const int rl = rl0 + ai * HALF + m * 16; const float sc = rs[rl]; bf16_t* rowp = O + (size_t)(u.pm * BM + rl) * ldc + col0;
#pragma unroll
                for (int bj = 0; bj < 2; ++bj) { const f32x4 v0 = acc[ai][bj][m][0] * sc, v1 = acc[ai][bj][m][1] * sc;
                    u32x4 w; w.x = cvt_pk_bf16(v0[0], v0[1]); w.y = cvt_pk_bf16(v0[2], v0[3]); w.z = cvt_pk_bf16(v1[0], v1[1]); w.w = cvt_pk_bf16(v1[2], v1[3]);
                    *(u32x4*)(rowp + bj * HALF) = w; } }
    }
};
struct EpiSwigluRS {
    static constexpr bool PERM = true, ROWSCALE = true;
    bf16_t* O; int ldc;
    __device__ __forceinline__ void operator()(const f32x4 (&acc)[2][2][4][2], const Unit& u, int wr, int wc, int fr, int fq, const PG8_LAS float* rs) const {
        const int rl0 = wr * 64 + fr, col0 = u.pn * HALF + wc * 32 + 8 * fq;
#pragma unroll
        for (int ai = 0; ai < 2; ++ai)
#pragma unroll
            for (int m = 0; m < 4; ++m) { const int rl = rl0 + ai * HALF + m * 16; const float sc = rs[rl]; bf16_t* rowp = O + (size_t)(u.pm * BM + rl) * ldc + col0;
                const float k1 = -1.4426950408889634f * sc, ik2 = __builtin_amdgcn_rcpf(sc * sc);
                float o[8];
#pragma unroll
                for (int n = 0; n < 2; ++n)
#pragma unroll
                    for (int j = 0; j < 4; ++j) { const float ag = acc[ai][0][m][n][j], au = acc[ai][1][m][n][j], e = __builtin_amdgcn_exp2f(ag * k1); o[n * 4 + j] = (ag * au) * __builtin_amdgcn_rcpf(fmaf(e, ik2, ik2)); }
                u32x4 w; w.x = cvt_pk_bf16(o[0], o[1]); w.y = cvt_pk_bf16(o[2], o[3]); w.z = cvt_pk_bf16(o[4], o[5]); w.w = cvt_pk_bf16(o[6], o[7]);
                *(u32x4*)rowp = w; }
    }
};
struct EpiBf16RopeRS {
    static constexpr bool PERM = true, ROWSCALE = true;
    bf16_t* O; int ldc; const int* pos;
    __device__ __forceinline__ void operator()(const f32x4 (&acc)[2][2][4][2], const Unit& u, int wr, int wc, int fr, int fq, const PG8_LAS float* rs) const {
        const int rl0 = wr * 64 + fr, col0 = u.pn * BM + wc * 32 + 8 * fq;
        const bool rot = u.pn < 16; const float ksc = (u.pn >= 8 && u.pn < 16) ? 0.0625f : 1.f;
        float inv[8];
#pragma unroll
        for (int j = 0; j < 8; ++j) inv[j] = __builtin_amdgcn_exp2f(-(float)(wc * 32 + 8 * fq + j) * (13.287712379549449f / 128.f));
#pragma unroll
        for (int ai = 0; ai < 2; ++ai)
#pragma unroll
            for (int m = 0; m < 4; ++m) { const int rl = rl0 + ai * HALF + m * 16, row = u.pm * BM + rl; const float sc = rs[rl] * ksc; bf16_t* rowp = O + (size_t)row * ldc + col0;
                float a1[8], a2[8];
#pragma unroll
                for (int n = 0; n < 2; ++n)
#pragma unroll
                    for (int j = 0; j < 4; ++j) { a1[n * 4 + j] = acc[ai][0][m][n][j] * sc; a2[n * 4 + j] = acc[ai][1][m][n][j] * sc; }
                if (rot) { const float p = (float)pos[row];
#pragma unroll
                    for (int j = 0; j < 8; ++j) { const float an = p * inv[j], sn = __sinf(an), cs = __cosf(an); const float x1 = a1[j], x2 = a2[j]; a1[j] = x1 * cs - x2 * sn; a2[j] = x1 * sn + x2 * cs; } }
                u32x4 w; w.x = cvt_pk_bf16(a1[0], a1[1]); w.y = cvt_pk_bf16(a1[2], a1[3]); w.z = cvt_pk_bf16(a1[4], a1[5]); w.w = cvt_pk_bf16(a1[6], a1[7]); *(u32x4*)rowp = w;
                w.x = cvt_pk_bf16(a2[0], a2[1]); w.y = cvt_pk_bf16(a2[2], a2[3]); w.z = cvt_pk_bf16(a2[4], a2[5]); w.w = cvt_pk_bf16(a2[6], a2[7]); *(u32x4*)(rowp + HALF) = w; }
    }
};

template <bool F8, class Epi, class Sched>
__device__ __forceinline__ void gemm_phase(PG8_LAS unsigned char* lds, const Gemm g, const Sched& S, const Epi& E) {
    int tid_ = threadIdx.x; asm volatile("" : "+v"(tid_));
    const int tid = tid_, wid = __builtin_amdgcn_readfirstlane(tid >> 6), lane = tid & 63, wr = wid >> 2, wc = wid & 3, fr = lane & 15, fq = lane >> 4;
    const int K = g.K, RB = F8 ? K : 2 * K  , nt = RB / 128;
    unsigned voffA[2], voffB[2];
#pragma unroll
    for (int i = 0; i < 2; ++i) { int R, C; stage_rc(tid * 16 + i * 8192, R, C); const int Rb = Epi::PERM ? ((R & ~31) + perm32(R & 31)) : R;
        voffA[i] = (unsigned)(R * RB + 2 * C); voffB[i] = (unsigned)(Rb * RB + 2 * C); }
    const size_t kstep = (size_t)(BK * 2);
    const size_t hstep = (size_t)HALF * RB;
    const size_t tstep = 2 * hstep;
    const unsigned ldsw = (unsigned)wid * 1024u;
    const int aoff = lds_byte(wr * 64 + fr, fq * 8), boff = lds_byte(wc * 32 + fr, fq * 8);
#define PG8_SA(b, h) (((b) * 2 + (h)) * HTB)
#define PG8_SB(b, h) ((4 + (b) * 2 + (h)) * HTB)
#define PG8_STAGE(bufoff, gbase, voff) do { _Pragma("unroll") for (int _i = 0; _i < 2; ++_i) \
        __builtin_amdgcn_global_load_lds((const unsigned*)((const char*)(gbase) + (voff)[_i]), (PG8_LAS unsigned*)(lds + (bufoff) + ldsw + _i * 8192), 16, 0, 0); } while (0)
#define PG8_LD2(p_) __builtin_shufflevector(*(const PG8_LAS v4i32*)(p_), *(const PG8_LAS v4i32*)((p_) + 1024), 0, 1, 2, 3, 4, 5, 6, 7)
#define PG8_LDA(dst, b, h) do { _Pragma("unroll") for (int m = 0; m < 4; ++m) dst[m] = PG8_LD2(lds + PG8_SA(b, h) + aoff + m * 2048); } while (0)
#define PG8_LDB(dst, b, h) do { _Pragma("unroll") for (int n = 0; n < 2; ++n) dst[n] = PG8_LD2(lds + PG8_SB(b, h) + boff + n * 2048); } while (0)
#define PG8_LO(x_) __builtin_bit_cast(bf16x8, __builtin_shufflevector(x_, x_, 0, 1, 2, 3))
#define PG8_HI(x_) __builtin_bit_cast(bf16x8, __builtin_shufflevector(x_, x_, 4, 5, 6, 7))
#define PG8_MMA(ai, bj, At, Bt) do { __builtin_amdgcn_s_setprio(1); _Pragma("unroll") for (int m = 0; m < 4; ++m) _Pragma("unroll") for (int n = 0; n < 2; ++n) { \
        if constexpr (F8) asm volatile("v_mfma_f32_16x16x128_f8f6f4 %0, %1, %2, %0" : "+v"(acc[ai][bj][m][n]) : "v"(Bt[n]), "v"(At[m]));     \
        else { acc[ai][bj][m][n] = __builtin_amdgcn_mfma_f32_16x16x32_bf16(PG8_LO(Bt[n]), PG8_LO(At[m]), acc[ai][bj][m][n], 0, 0, 0); \
               acc[ai][bj][m][n] = __builtin_amdgcn_mfma_f32_16x16x32_bf16(PG8_HI(Bt[n]), PG8_HI(At[m]), acc[ai][bj][m][n], 0, 0, 0); } } __builtin_amdgcn_s_setprio(0); } while (0)
#define PG8_WAIT_V(n) asm volatile("s_waitcnt vmcnt(" #n ")" ::: "memory")
#define PG8_WAIT_L(n) asm volatile("s_waitcnt lgkmcnt(" #n ")" ::: "memory")
#define PG8_BAR __builtin_amdgcn_s_barrier()
#define PG8_SCHED __builtin_amdgcn_sched_barrier(0)
    Unit cur, nxt; int ui = 0, rs_pm = -1;
    if (!S.next(0, cur)) return;
    f32x4 acc[2][2][4][2];
#pragma unroll
    for (int a = 0; a < 2; ++a)
#pragma unroll
        for (int b = 0; b < 2; ++b)
#pragma unroll
            for (int m = 0; m < 4; ++m)
#pragma unroll
                for (int n = 0; n < 2; ++n) acc[a][b][m][n] = (f32x4){0.f, 0.f, 0.f, 0.f};
    v8i32 At[4], B0[2], B1[2];
    const char* cA = (const char*)g.A + (size_t)cur.pm * tstep; const char* cB = (const char*)g.Bt + (size_t)cur.pn * tstep + S.boff(cur);
    PG8_STAGE(PG8_SB(0, 0), cB, voffB); PG8_STAGE(PG8_SB(0, 1), cB + hstep, voffB); PG8_STAGE(PG8_SA(0, 0), cA, voffA); PG8_STAGE(PG8_SA(0, 1), cA + hstep, voffA);
    if (wr == 1) PG8_BAR;
    PG8_WAIT_V(2); PG8_BAR;
    PG8_STAGE(PG8_SB(1, 0), cB + kstep, voffB); PG8_STAGE(PG8_SA(1, 0), cA + kstep, voffA); PG8_STAGE(PG8_SB(1, 1), cB + hstep + kstep, voffB);
    PG8_WAIT_V(6); PG8_BAR;
    for (;;) {
        const bool has_next = S.next(ui + 1, nxt);
        const char* nA = has_next ? (const char*)g.A + (size_t)nxt.pm * tstep : cA; const char* nB = has_next ? (const char*)g.Bt + (size_t)nxt.pn * tstep + S.boff(nxt) : cB;
        for (int t = 0; t < nt; t += 2) {
            const bool last = (t == nt - 2);
            const char* a1 = cA + (size_t)(t + 1) * kstep;
            const char* a2 = last ? nA : cA + (size_t)(t + 2) * kstep; const char* b2 = last ? nB : cB + (size_t)(t + 2) * kstep;
            const char* a3 = a2 + kstep; const char* b3 = b2 + kstep;
            PG8_LDB(B0, 0, 0); PG8_LDB(B1, 0, 1); PG8_SCHED; PG8_LDA(At, 0, 0); PG8_STAGE(PG8_SA(1, 1), a1 + hstep, voffA);
            PG8_WAIT_V(8); PG8_WAIT_L(0); PG8_BAR; PG8_MMA(0, 0, At, B0); PG8_MMA(0, 1, At, B1); PG8_BAR; PG8_SCHED;
            PG8_LDA(At, 0, 1); PG8_STAGE(PG8_SB(0, 0), b2, voffB); PG8_STAGE(PG8_SB(0, 1), b2 + hstep, voffB); PG8_STAGE(PG8_SA(0, 0), a2, voffA);
            PG8_WAIT_V(8); PG8_WAIT_L(0); PG8_BAR; PG8_MMA(1, 0, At, B0); PG8_MMA(1, 1, At, B1); PG8_BAR; PG8_SCHED;
            PG8_LDB(B0, 1, 0); PG8_LDB(B1, 1, 1); PG8_SCHED; PG8_LDA(At, 1, 0); PG8_STAGE(PG8_SA(0, 1), a2 + hstep, voffA);
            PG8_WAIT_V(8); PG8_WAIT_L(0); PG8_BAR; PG8_MMA(0, 0, At, B0); PG8_MMA(0, 1, At, B1); PG8_BAR; PG8_SCHED;
            PG8_LDA(At, 1, 1); PG8_STAGE(PG8_SB(1, 0), b3, voffB); PG8_STAGE(PG8_SB(1, 1), b3 + hstep, voffB); PG8_STAGE(PG8_SA(1, 0), a3, voffA);
            PG8_WAIT_V(8); PG8_WAIT_L(0); PG8_BAR; PG8_MMA(1, 0, At, B0); PG8_MMA(1, 1, At, B1); PG8_BAR; PG8_SCHED;
        }
        if constexpr (F8) asm volatile("s_nop 15\n\ts_nop 15" ::: "memory");
        if (wr == 0) PG8_BAR;
        { int l2 = threadIdx.x; asm volatile("" : "+v"(l2));
          const PG8_LAS float* rsT = (const PG8_LAS float*)(lds + RS_LDS_OFF);
          if (Epi::ROWSCALE && cur.pm != rs_pm) {
              rs_pm = cur.pm;
              if (l2 < 256) { const f32x4* pr = (const f32x4*)(g.rss + (size_t)(cur.pm * BM + l2) * 32); f32x4 t = pr[0];
#pragma unroll
                  for (int q = 1; q < 8; ++q) t += pr[q];
                  ((PG8_LAS float*)(lds + RS_LDS_OFF))[l2] = rsqrtf(((t[0] + t[1]) + (t[2] + t[3])) * (1.f / 2048.f) + 1e-6f); }
              PG8_WAIT_L(0); PG8_BAR; asm volatile("" ::: "memory"); }
          E(acc, cur, wr, wc, l2 & 15, (l2 >> 4) & 3, rsT); }
        if (!has_next) break;
#pragma unroll
        for (int a = 0; a < 2; ++a)
#pragma unroll
            for (int b = 0; b < 2; ++b)
#pragma unroll
                for (int m = 0; m < 4; ++m)
#pragma unroll
                    for (int n = 0; n < 2; ++n) acc[a][b][m][n] = (f32x4){0.f, 0.f, 0.f, 0.f};
        cur = nxt; cA = nA; cB = nB; ++ui;
        if (wr == 1) PG8_BAR;
    }
    PG8_WAIT_V(0);
    PG8_BAR;
#undef PG8_SA
#undef PG8_SB
#undef PG8_STAGE
#undef PG8_LDA
#undef PG8_LDB
#undef PG8_MMA
#undef PG8_LD2
#undef PG8_LO
#undef PG8_HI
#undef PG8_WAIT_V
#undef PG8_WAIT_L
#undef PG8_BAR
#undef PG8_SCHED
}
}

constexpr int NTHR = 512, NWAVES = 8;
constexpr int LDS_BYTES = 147456;
constexpr int MISC_OFF = 135168;
constexpr int RQ_OUT = MISC_OFF + 2048;
static_assert(RQ_OUT + 64 * 144 <= LDS_BYTES, "output staging");

struct Ctx { int tid, lane, wave, gw, ngw; };

__device__ __forceinline__ void rope32(float& v0, float& v1, float pos, int lane) {
    const float o0 = __shfl_xor(v0, 8), o1 = __shfl_xor(v1, 8);
    if (lane < 16) {
        const int j0 = (2 * lane) & 15;
        const float i0 = __powf(500000.f, -(float)j0 * (1.f / 16.f)), i1 = __powf(500000.f, -(float)(j0 + 1) * (1.f / 16.f));
        const float s0 = __sinf(pos * i0), c0 = __cosf(pos * i0), s1 = __sinf(pos * i1), c1 = __cosf(pos * i1);
        if (lane < 8) { v0 = v0 * c0 - o0 * s0; v1 = v1 * c1 - o1 * s1; }
        else          { v0 = o0 * s0 + v0 * c0; v1 = o1 * s1 + v1 * c1; }
    }
}

template <bool F8 = false>
__device__ __forceinline__ void tr_seg(const float* __restrict__ W, int K, int Ns, int col0, int ncols, void* dstv, int mode, int p0, LAS float* scr, const Ctx& c, int& rot, float wscale = 1.f, const float* kg = nullptr) {
    bf16* dst = (bf16*)dstv;
    const int nnb = ncols / 64, nitems = (K / 64) * nnb;
    int it = c.gw - rot; if (it < 0) it += c.ngw;
    for (; it < nitems; it += c.ngw) {
        const int kb = it / nnb, nb = it - kb * nnb, k0 = kb * 64, n0 = nb * 64;
        const float* src = W + (size_t)k0 * Ns + col0 + n0 + c.lane;
#pragma unroll 16
        for (int i = 0; i < 64; ++i) scr[i * 65 + c.lane] = src[(size_t)i * Ns];
        LDS_WAIT(); asm volatile("" ::: "memory");
        const int ch = c.lane >> 3, nn = c.lane & 7;
        float gm[8];
#pragma unroll
        for (int i = 0; i < 8; ++i) gm[i] = wscale;
        if (kg) { const f32x4 ga = *(const f32x4*)(kg + k0 + 8 * ch), gb = *(const f32x4*)(kg + k0 + 8 * ch + 4); gm[0] *= ga.x; gm[1] *= ga.y; gm[2] *= ga.z; gm[3] *= ga.w; gm[4] *= gb.x; gm[5] *= gb.y; gm[6] *= gb.z; gm[7] *= gb.w; }
#pragma unroll
        for (int j = 0; j < 8; ++j) { const int n = nn + 8 * j; const LAS float* s = scr + (8 * ch) * 65 + n;
            const int ng = n0 + n, drow = mode ? ((ng >> 7) * 256 + p0 * 128 + (ng & 127)) : (p0 + ng);
            if constexpr (F8) { u32x2 o; o.x = pk4_fp8(s[0] * gm[0], s[65] * gm[1], s[130] * gm[2], s[195] * gm[3]); o.y = pk4_fp8(s[260] * gm[4], s[325] * gm[5], s[390] * gm[6], s[455] * gm[7]);
                *(u32x2*)((unsigned char*)dstv + (size_t)drow * K + k0 + 8 * ch) = o; }
            else { u32x4 o; o.x = pk2(s[0] * gm[0], s[65] * gm[1]); o.y = pk2(s[130] * gm[2], s[195] * gm[3]); o.z = pk2(s[260] * gm[4], s[325] * gm[5]); o.w = pk2(s[390] * gm[6], s[455] * gm[7]);
                *(u32x4*)(dst + (size_t)drow * K + k0 + 8 * ch) = o; } }
        LDS_WAIT(); asm volatile("" ::: "memory");
    }
    rot = (rot + nitems) % c.ngw;
}
__device__ __forceinline__ void x_row_bf16(const float* xrow, bf16* orow, float* rssrow, int lane) {
    const f32x4* xr = (const f32x4*)xrow + 2 * lane; f32x4 v[8]; float s = 0.f;
#pragma unroll
    for (int j = 0; j < 4; ++j) { v[2 * j] = xr[128 * j]; v[2 * j + 1] = xr[128 * j + 1]; }
#pragma unroll
    for (int j = 0; j < 8; ++j) s += (v[j].x * v[j].x + v[j].y * v[j].y) + (v[j].z * v[j].z + v[j].w * v[j].w);
    s = wave_sum(s);
#pragma unroll
    for (int j = 0; j < 4; ++j) { u32x4 w; w.x = pk2(v[2 * j].x, v[2 * j].y); w.y = pk2(v[2 * j].z, v[2 * j].w); w.z = pk2(v[2 * j + 1].x, v[2 * j + 1].y); w.w = pk2(v[2 * j + 1].z, v[2 * j + 1].w);
        ((u32x4*)orow)[64 * j + lane] = w; }
    if (lane < 32) rssrow[lane] = lane == 0 ? s : 0.f;
}
__device__ __forceinline__ void ph_prologue(KArgs a, LAS unsigned char* lds, const Ctx& c) {
    LAS float* scr = (LAS float*)(lds + c.wave * 16640);
    unsigned char* ws = a.ws; int rot = 0;
    bf16* wie = (bf16*)(ws + WS_WIE);
    tr_seg(a.in[I_WIE], DM, EVEN_IN, 0, 2560, wie, 0, 0, scr, c, rot, 1.f, a.in[I_NME]);
    tr_seg(a.in[I_WIE], DM, EVEN_IN, 2584, 3072, wie, 0, 2560, scr, c, rot, 1.f, a.in[I_NME]);
    tr_seg(a.in[I_WIE], DM, EVEN_IN, 5664, 1024, wie, 0, 5632, scr, c, rot, 1.f, a.in[I_NME]);
    tr_seg(a.in[I_WOE], DM, DM, 0, DM, (bf16*)(ws + WS_WOE), 0, 0, scr, c, rot);
    tr_seg(a.in[I_FG], DM, FFN, 0, FFN, ws + WS_WGU, 1, 0, scr, c, rot, 1.f, a.in[I_NFE]);
    tr_seg(a.in[I_FU], DM, FFN, 0, FFN, ws + WS_WGU, 1, 1, scr, c, rot, 1.f, a.in[I_NFE]);
    tr_seg(a.in[I_FD], FFN, DM, 0, DM, ws + WS_WD, 0, 0, scr, c, rot);
    tr_seg(a.in[I_WIO], DM, ODD_IN, 0, ODD_IN, (bf16*)(ws + WS_WIO), 0, 0, scr, c, rot, 1.f, a.in[I_NMO]);
    tr_seg(a.in[I_WOO], 2 * DM, DM, 0, DM, (bf16*)(ws + WS_WOO), 0, 0, scr, c, rot);
    for (int e = 0; e < NEXP; ++e) {
        tr_seg<true>(a.in[I_EG] + (size_t)e * DM * FFN, DM, FFN, 0, FFN, ws + WS_EGU + (size_t)e * 2 * FFN * DM, 1, 0, scr, c, rot, 64.f, a.in[I_NFO]);
        tr_seg<true>(a.in[I_EU] + (size_t)e * DM * FFN, DM, FFN, 0, FFN, ws + WS_EGU + (size_t)e * 2 * FFN * DM, 1, 1, scr, c, rot, 64.f, a.in[I_NFO]);
        tr_seg<true>(a.in[I_ED] + (size_t)e * DM * FFN, FFN, DM, 0, DM, ws + WS_ED + (size_t)e * FFN * DM, 0, 0, scr, c, rot, 64.f);
    }
    tr_seg(a.in[I_WCK], 32 * HD, HD, 0, HD, (bf16*)(ws + WS_WCK), 0, 0, scr, c, rot);
    tr_seg(a.in[I_WCV], 32 * HD, HD, 0, HD, (bf16*)(ws + WS_WCV), 0, 0, scr, c, rot);
    for (int idx = c.gw * 64 + c.lane; idx < 256 * DM; idx += c.ngw * 64) {
        const int r = idx / DM, k = idx - r * DM; float v = 0.f;
        if (r < 32) { const int sc = r < 24 ? 2560 + r : 5656 + (r - 24); v = a.in[I_WIE][(size_t)k * EVEN_IN + sc] * a.in[I_NME][k]; }
        wie[(size_t)(6656 + r) * DM + k] = (bf16)f2bf(v);
    }
    for (int o = c.gw; o < 256; o += c.ngw) { const int which = o >> 7, e = o & 127; const float* w = a.in[which ? I_WCV : I_WCK]; float s = 0.f;
        for (int k = c.lane; k < 32 * HD; k += 64) s += a.in[I_PE][k] * w[(size_t)k * HD + e];
        s = wave_sum(s); if (c.lane == 0) ((float*)(ws + WS_MISC + MS_PEW))[o] = s; }
    for (int m = c.gw; m < MTOK; m += c.ngw) x_row_bf16(a.in[I_X] + (size_t)m * DM, (bf16*)(ws + WS_H) + (size_t)m * DM, (float*)(ws + WS_RSS) + (size_t)m * 32, c.lane);
}
__device__ __forceinline__ void ph_prep0(KArgs a, const Ctx& c) {
    unsigned char* ws = a.ws; const bf16* Y0 = (const bf16*)(ws + WS_Y0); const int lane = c.lane;
    const float* qg = a.in[I_QG]; const float* kg = a.in[I_KG]; const int* posv = (const int*)a.in[I_POS]; const float* cw = a.in[I_CONV];
    const float qg0 = qg[2 * lane], qg1 = qg[2 * lane + 1], kg0 = kg[2 * lane], kg1 = kg[2 * lane + 1];
    const int j0 = (2 * lane) & 15;
    const float i0 = __powf(500000.f, -(float)j0 * (1.f / 16.f)), i1 = __powf(500000.f, -(float)(j0 + 1) * (1.f / 16.f));
    const int m0 = c.gw * 8;
#pragma unroll 4
    for (int m = m0; m < m0 + 8; ++m) {
        const bf16* yr = Y0 + (size_t)m * LDY0; const float pos = (float)posv[m];
        unsigned w[12];
#pragma unroll
        for (int hh = 0; hh < 12; ++hh) { const int scol = hh < 8 ? YQ + hh * HD : (hh < 10 ? YKS + (hh - 8) * HD : YKW + (hh - 10) * HD); w[hh] = *(const unsigned*)(yr + scol + 2 * lane); }
        const float s0 = __sinf(pos * i0), c0 = __cosf(pos * i0), s1 = __sinf(pos * i1), c1 = __cosf(pos * i1);
#pragma unroll
        for (int hh = 0; hh < 12; ++hh) {
            float v0 = lo16(w[hh]), v1 = hi16(w[hh]);
            const float r = rsqrtf(wave_sum(v0 * v0 + v1 * v1) * (1.f / HD) + RMS_EPS);
            v0 *= r * (hh < 8 ? qg0 : kg0); v1 *= r * (hh < 8 ? qg1 : kg1);
            const float o0 = __shfl_xor(v0, 8), o1 = __shfl_xor(v1, 8);
            if (lane < 8) { v0 = v0 * c0 - o0 * s0; v1 = v1 * c1 - o1 * s1; }
            else if (lane < 16) { v0 = o0 * s0 + v0 * c0; v1 = o1 * s1 + v1 * c1; }
            bf16* dst = hh < 8 ? (bf16*)(ws + WS_QN) + (size_t)m * 1024 + hh * HD : (hh < 10 ? (bf16*)(ws + WS_KSN) + (size_t)m * 256 + (hh - 8) * HD : (bf16*)(ws + WS_KWN) + (size_t)m * 256 + (hh - 10) * HD);
            *(unsigned*)(dst + 2 * lane) = pk2(v0, v1);
        }
    }
    const bool hist = (m0 & (SEQ - 1)) > 0;
#pragma unroll 1
    for (int j = 0; j < 4; ++j) { const int ch = 8 * (lane + 64 * j);
        f32x4 wa[4], wb[4];
#pragma unroll
        for (int i = 0; i < 4; ++i) { wa[i] = *(const f32x4*)(cw + i * 2048 + ch); wb[i] = *(const f32x4*)(cw + i * 2048 + ch + 4); }
        const bf16* col = Y0 + (size_t)m0 * LDY0 + YMQ + ch;
        u32x4 x0 = (u32x4){0u, 0u, 0u, 0u}, x1 = x0, x2 = x0;
        if (hist) { x0 = *(const u32x4*)(col - 3 * (ptrdiff_t)LDY0); x1 = *(const u32x4*)(col - 2 * (ptrdiff_t)LDY0); x2 = *(const u32x4*)(col - (ptrdiff_t)LDY0); }
        const float sc = ch >= 1024 ? 0.0625f : 1.f;
        bf16* dstc = ch >= 1024 ? (bf16*)(ws + WS_MK) + (size_t)m0 * 1024 + (ch - 1024) : (bf16*)(ws + WS_MQ) + (size_t)m0 * 1024 + ch;
        u32x4 xr[8];
#pragma unroll
        for (int i = 0; i < 8; ++i) xr[i] = *(const u32x4*)(col + (size_t)i * LDY0);
#pragma unroll
        for (int i = 0; i < 8; ++i) { const u32x4 x3 = xr[i]; float acc[8];
#pragma unroll
            for (int e = 0; e < 8; ++e) acc[e] = 0.f;
#define CONV_TAP(XV, k) acc[0] += lo16(XV.x) * wa[k].x; acc[1] += hi16(XV.x) * wa[k].y; acc[2] += lo16(XV.y) * wa[k].z; acc[3] += hi16(XV.y) * wa[k].w; acc[4] += lo16(XV.z) * wb[k].x; acc[5] += hi16(XV.z) * wb[k].y; acc[6] += lo16(XV.w) * wb[k].z; acc[7] += hi16(XV.w) * wb[k].w;
            CONV_TAP(x0, 0) CONV_TAP(x1, 1) CONV_TAP(x2, 2) CONV_TAP(x3, 3)
#undef CONV_TAP
#pragma unroll
            for (int e = 0; e < 8; ++e) acc[e] = siluf_(acc[e]) * sc;
            u32x4 o; o.x = pk2(acc[0], acc[1]); o.y = pk2(acc[2], acc[3]); o.z = pk2(acc[4], acc[5]); o.w = pk2(acc[6], acc[7]);
            *(u32x4*)(dstc + (size_t)i * 1024) = o;
            x0 = x1; x1 = x2; x2 = x3; }
    }
}
__device__ __forceinline__ void ph_compress(KArgs a, LAS unsigned char* lds, const Ctx& c) {
    unsigned char* ws = a.ws; const bf16* Y0 = (const bf16*)(ws + WS_Y0); const int lane = c.lane, wave = c.wave;
    const int* posv = (const int*)a.in[I_POS];
    LAS unsigned char* At = lds;
    LAS float* Ot = (LAS float*)(lds + 272 * 272);
    for (int u = blockIdx.x; u < 256; u += gridDim.x) {
        const int which = u >> 7, b = (u >> 5) & 3, g = (u >> 4) & 1, cb = u & 15, t0 = cb * 256;
        const int scol = (which ? YVC : YKC) + g * HD;
        __syncthreads();
        for (int idx = c.tid; idx < 272 * 16; idx += NTHR) { const int r = idx >> 4, q = idx & 15; const int t = t0 + r;
            u32x4 v = (u32x4){0u, 0u, 0u, 0u}; if (t < SEQ) v = *(const u32x4*)(Y0 + (size_t)(b * SEQ + t) * LDY0 + scol + q * 8);
            *(LAS u32x4*)(At + r * 272 + q * 16) = v; }
        __syncthreads();
        const bf16* Wt = (const bf16*)(ws + (which ? WS_WCV : WS_WCK));
        const int fr = lane & 15, fq = lane >> 4, e = wave * 16 + fr;
        f32x4 acc = (f32x4){0.f, 0.f, 0.f, 0.f};
        const bf16* wrow = Wt + (size_t)e * 4096 + fq * 8;
#pragma unroll 16
        for (int s = 0; s < 128; ++s) {
            const bf16x8 bfr = *(const bf16x8*)(wrow + s * 32);
            const bf16x8 afr = *(const LAS bf16x8*)(At + (16 * fr + (s >> 2)) * 272 + ((s & 3) * 32 + fq * 8) * 2);
            acc = __builtin_amdgcn_mfma_f32_16x16x32_bf16(afr, bfr, acc, 0, 0, 0);
        }
        const float pw = ((const float*)(ws + WS_MISC + MS_PEW))[which * 128 + e];
#pragma unroll
        for (int r = 0; r < 4; ++r) Ot[(4 * fq + r) * 128 + e] = acc[r] + pw;
        __syncthreads();
#pragma unroll
        for (int rr = 0; rr < 2; ++rr) { const int cl = 2 * wave + rr, cg = cb * 16 + cl;
            float v0 = Ot[cl * 128 + 2 * lane], v1 = Ot[cl * 128 + 2 * lane + 1];
            bf16* dst = (bf16*)(ws + (which ? WS_VCC : WS_KCN)) + ((size_t)((b * 2 + g) * 256 + cg)) * HD + 2 * lane;
            if (cg >= NC) { v0 = 0.f; v1 = 0.f; }
            else if (!which) { const float r = rsqrtf(wave_sum(v0 * v0 + v1 * v1) * (1.f / HD) + RMS_EPS); v0 *= r * a.in[I_KG][2 * lane]; v1 *= r * a.in[I_KG][2 * lane + 1];
                rope32(v0, v1, (float)posv[b * SEQ + 31 + 16 * cg], lane); }
            *(unsigned*)dst = pk2(v0, v1); }
        if (which && c.tid < 128) {
            const int d = c.tid; unsigned w[8];
#pragma unroll
            for (int k = 0; k < 8; ++k) { const float a0 = (cb * 16 + 2 * k) < NC ? Ot[(2 * k) * 128 + d] : 0.f, a1 = (cb * 16 + 2 * k + 1) < NC ? Ot[(2 * k + 1) * 128 + d] : 0.f; w[k] = pk2(a0, a1); }
            u32x4* dstT = (u32x4*)((bf16*)(ws + WS_VCT) + ((size_t)((b * 2 + g) * 128 + d)) * 256 + cb * 16);
            dstT[0] = (u32x4){w[0], w[1], w[2], w[3]}; dstT[1] = (u32x4){w[4], w[5], w[6], w[7]}; }
    }
}

__device__ __forceinline__ void ph_vtrans(KArgs a, LAS unsigned char* lds, const Ctx& c) {
    unsigned char* ws = a.ws; const bf16* Y0 = (const bf16*)(ws + WS_Y0);
    for (int u = blockIdx.x; u < 1024; u += gridDim.x) {
        const int tb = u & 63, g = (u >> 6) & 1, b = (u >> 7) & 3, which = u >> 9;
        const int scol = (which ? YVW : YVS) + g * HD; bf16* dst = (bf16*)(ws + (which ? WS_VWT : WS_VST)) + (size_t)((b * 2 + g) * 128) * SEQ + tb * 64;
        __syncthreads();
        { const int t = c.tid >> 3, q = c.tid & 7; const bf16* src = Y0 + (size_t)(b * SEQ + tb * 64 + t) * LDY0 + scol + q * 16;
          const u32x4 v0 = *(const u32x4*)src, v1 = *(const u32x4*)(src + 8);
          *(LAS u32x4*)(lds + t * 272 + q * 32) = v0; *(LAS u32x4*)(lds + t * 272 + q * 32 + 16) = v1; }
        __syncthreads();
        { const int d = c.tid >> 2, tq = c.tid & 3; unsigned w[8];
#pragma unroll
          for (int k = 0; k < 8; ++k) { const unsigned lo = *(const LAS unsigned short*)(lds + (tq * 16 + 2 * k) * 272 + d * 2), hi = *(const LAS unsigned short*)(lds + (tq * 16 + 2 * k + 1) * 272 + d * 2); w[k] = lo | (hi << 16); }
          u32x4* o = (u32x4*)(dst + (size_t)d * SEQ + tq * 16); o[0] = (u32x4){w[0], w[1], w[2], w[3]}; o[1] = (u32x4){w[4], w[5], w[6], w[7]}; }
    }
}

typedef float f32x16 __attribute__((ext_vector_type(16)));
typedef short s16x4 __attribute__((ext_vector_type(4)));
__device__ __forceinline__ s16x4 lds_tr16(const LAS unsigned char* p) { typedef short v4i16_t __attribute__((ext_vector_type(4))); return __builtin_bit_cast(s16x4, __builtin_amdgcn_ds_read_tr16_b64_v4i16((LAS v4i16_t*)p)); }
constexpr int NSA_BUF = 32768, NSA_IMP_OFF = 65536, NSA_MASK_OFF = NSA_IMP_OFF + 64 * 65 * 4;
__device__ __forceinline__ void nsa_issue(LAS unsigned char* buf, const char* kbase, size_t kstride, const char* vbase, size_t vstride, int wave, int lane) {
#pragma unroll
    for (int i = 0; i < 2; ++i) { const int q = wave * 2 + i, row = 4 * q + (lane >> 4), ch = (lane & 15) ^ (row & 15);
        __builtin_amdgcn_global_load_lds((const unsigned*)(kbase + (size_t)row * kstride + ch * 16), (LAS unsigned*)(buf + q * 1024), 16, 0, 0); }
#pragma unroll
    for (int i = 0; i < 2; ++i) { const int q = wave * 2 + i, row = 8 * q + (lane >> 3), ch = (lane & 7) ^ (row & 7);
        __builtin_amdgcn_global_load_lds((const unsigned*)(vbase + (size_t)row * vstride + ch * 16), (LAS unsigned*)(buf + 16384 + q * 1024), 16, 0, 0); }
}
__device__ __forceinline__ void nsa_scores(f32x16& p, const LAS unsigned char* buf, int ln, const bf16x8 (&Q)[8], int hh) {
    const int r = ln & 31, x0 = (r & 15) ^ (ln >> 5); const LAS unsigned char* kb = buf + r * 256 + hh * 8192;
#pragma unroll
    for (int i = 0; i < 16; ++i) p[i] = 0.f;
#pragma unroll
    for (int s = 0; s < 8; ++s) { const bf16x8 a0 = *(const LAS bf16x8*)(kb + (((2 * s) ^ x0) << 4));
        p = __builtin_amdgcn_mfma_f32_32x32x16_bf16(a0, Q[s], p, 0, 0, 0);
        if ((s & 3) == 3) __builtin_amdgcn_sched_barrier(0); }
}
__device__ __forceinline__ float half_max(float m) { auto rr = __builtin_amdgcn_permlane32_swap(__float_as_uint(m), __float_as_uint(m), false, false); return fmaxf(__uint_as_float(rr[0]), __uint_as_float(rr[1])); }
__device__ __forceinline__ float half_sum(float m) { auto rr = __builtin_amdgcn_permlane32_swap(__float_as_uint(m), __float_as_uint(m), false, false); return __uint_as_float(rr[0]) + __uint_as_float(rr[1]); }
__device__ __forceinline__ float tile_max(const f32x16& p) {
    float a = fmaxf(p[0], p[1]);
#pragma unroll
    for (int i = 2; i < 16; ++i) a = fmaxf(a, p[i]);
    return half_max(a);
}
__device__ __forceinline__ bf16x8 pack8(const f32x16& p, int o) {
    u32x4 w; w.x = pg8::cvt_pk_bf16(p[o], p[o + 1]); w.y = pg8::cvt_pk_bf16(p[o + 2], p[o + 3]); w.z = pg8::cvt_pk_bf16(p[o + 4], p[o + 5]); w.w = pg8::cvt_pk_bf16(p[o + 6], p[o + 7]);
    return __builtin_bit_cast(bf16x8, w);
}
__device__ __forceinline__ void nsa_pv(f32x16 (&O)[4], const LAS unsigned char* buf, int ln, const f32x16& p, int hh) {
    const int r = ln & 31, xv = r & 7; const LAS unsigned char* vb = buf + 16384 + r * 128 + 8 * (ln >> 5);
    bf16x8 P[2]; P[0] = pack8(p, 0); P[1] = pack8(p, 8);
#pragma unroll
    for (int dt = 0; dt < 4; ++dt) {
#pragma unroll
        for (int s2 = 0; s2 < 2; ++s2) { const int s = 2 * hh + s2; const s16x4 lo = *(const LAS s16x4*)(vb + dt * 4096 + (((2 * s) ^ xv) << 4)), hi = *(const LAS s16x4*)(vb + dt * 4096 + (((2 * s + 1) ^ xv) << 4));
            const bf16x8 av = (bf16x8){lo[0], lo[1], lo[2], lo[3], hi[0], hi[1], hi[2], hi[3]};
            O[dt] = __builtin_amdgcn_mfma_f32_32x32x16_bf16(av, P[s2], O[dt], 0, 0, 0); }
        if (dt & 1) __builtin_amdgcn_sched_barrier(0); }
}
__device__ __forceinline__ void nsa_mask(f32x16& p, int kb, int klo, int khi) {
#pragma unroll
    for (int i = 0; i < 16; ++i) { const int k = kb + (i & 3) + 8 * (i >> 2); if (k < klo || k > khi) p[i] = -3.0e38f; }
}
__device__ __forceinline__ void nsa_step(f32x16& p, float bias, float c2, float& m, float& l, f32x16 (&O)[4], const LAS unsigned char* buf, int ln, int hh) {
    const float tm = tile_max(p) * c2 + bias;
    if (__builtin_amdgcn_ballot_w64(tm > m + 8.f) != 0ull) {
        const float mn = fmaxf(m, tm), alpha = __builtin_amdgcn_exp2f(m - mn); l *= alpha; m = mn;
#pragma unroll
        for (int dt = 0; dt < 4; ++dt)
#pragma unroll
            for (int i = 0; i < 16; ++i) O[dt][i] *= alpha; }
    const float nb = bias - m; float rs = 0.f;
#pragma unroll
    for (int i = 0; i < 16; ++i) { p[i] = __builtin_amdgcn_exp2f(fmaf(p[i], c2, nb)); rs += p[i]; }
    l += half_sum(rs);
    nsa_pv(O, buf, ln, p, hh);
}
template <bool ACC> __device__ __forceinline__ void nsa_out(bf16* orow0, int hf, const f32x16 (&O)[4], float w) {
#pragma unroll
    for (int dt = 0; dt < 4; ++dt)
#pragma unroll
        for (int m2 = 0; m2 < 2; ++m2) { float A[4], B[4];
#pragma unroll
            for (int j = 0; j < 4; ++j) { const auto rr = __builtin_amdgcn_permlane32_swap(__float_as_uint(O[dt][8 * m2 + j] * w), __float_as_uint(O[dt][8 * m2 + 4 + j] * w), false, false); A[j] = __uint_as_float(rr[0]); B[j] = __uint_as_float(rr[1]); }
            u32x4* ptr = (u32x4*)(orow0 + 32 * dt + 16 * m2 + 8 * hf);
            if (ACC) { const u32x4 old = *ptr; A[0] += lo16(old.x); A[1] += hi16(old.x); A[2] += lo16(old.y); A[3] += hi16(old.y); B[0] += lo16(old.z); B[1] += hi16(old.z); B[2] += lo16(old.w); B[3] += hi16(old.w); }
            u32x4 o; o.x = pg8::cvt_pk_bf16(A[0], A[1]); o.y = pg8::cvt_pk_bf16(A[2], A[3]); o.z = pg8::cvt_pk_bf16(B[0], B[1]); o.w = pg8::cvt_pk_bf16(B[2], B[3]); *ptr = o; }
}
#define NSA_SYNC() do { asm volatile("s_waitcnt vmcnt(0) lgkmcnt(0)" ::: "memory"); __builtin_amdgcn_s_barrier(); asm volatile("" ::: "memory"); } while (0)
#define NSA_ZERO_O() do { _Pragma("unroll") for (int dt = 0; dt < 4; ++dt) _Pragma("unroll") for (int i = 0; i < 16; ++i) O[dt][i] = 0.f; } while (0)

__device__ __forceinline__ void ph_nsa(KArgs a, LAS unsigned char* lds, const Ctx& c) {
    unsigned char* ws = a.ws; const int wave = c.wave, p = wave & 3, th = wave >> 2;
    const bf16* Y0 = (const bf16*)(ws + WS_Y0); const bf16* QN = (const bf16*)(ws + WS_QN); bf16* MIXED = (bf16*)(ws + WS_MIXED);
    LAS unsigned* imp = (LAS unsigned*)(lds + NSA_IMP_OFF); LAS unsigned long long* msk = (LAS unsigned long long*)(lds + NSA_MASK_OFF);
    const float c2 = 0.08838834764831845f * 1.4426950408889634f;
    unsigned* qhead = (unsigned*)(ws + WS_CTL) + CW_NSAQ;
    LAS unsigned* qslot = (LAS unsigned*)(lds + NSA_MASK_OFF + 512);
    for (;;) {
        __syncthreads();
        if (threadIdx.x == 0) {
            unsigned got = 0xffffffffu;
            for (int k = 0; k < 8 && got == 0xffffffffu; ++k) { const unsigned q = (blockIdx.x + k) & 7u;
                if (__hip_atomic_load(qhead + 64 * q, __ATOMIC_RELAXED, __HIP_MEMORY_SCOPE_AGENT) < 64u) { const unsigned i = __hip_atomic_fetch_add(qhead + 64 * q, 1u, __ATOMIC_RELAXED, __HIP_MEMORY_SCOPE_AGENT); if (i < 64u) got = i * 8u + q; } }
            qslot[0] = got; }
        __syncthreads();
        const int wi = (int)qslot[0]; if (wi < 0) break;
        int tid_o = threadIdx.x; asm volatile("" : "+v"(tid_o)); const int lane = tid_o & 63;
        const int r = lane & 31, h = lane >> 5;
        const int bg = wi & 7, qc = 63 - (wi >> 3), b = bg >> 1, g = bg & 1, t0 = qc * 64;
        const int tq = t0 + 32 * th + r; const size_t m = (size_t)b * SEQ + tq;
        const char* KC = (const char*)(ws + WS_KCN) + (size_t)bg * 256 * 256; const char* VCT = (const char*)(ws + WS_VCT) + (size_t)bg * 128 * 512;
        const char* KS = (const char*)(ws + WS_KSN) + ((size_t)b * SEQ * 256 + g * HD) * 2; const char* VST = (const char*)(ws + WS_VST) + (size_t)bg * 128 * SEQ * 2;
        const char* KW = (const char*)(ws + WS_KWN) + ((size_t)b * SEQ * 256 + g * HD) * 2; const char* VWT = (const char*)(ws + WS_VWT) + (size_t)bg * 128 * SEQ * 2;
        __syncthreads();
        for (int i = tid_o; i < 64 * 65; i += NTHR) imp[i] = 0u;
        bf16x8 Q[8];
#pragma unroll
        for (int s = 0; s < 8; ++s) Q[s] = *(const bf16x8*)(QN + m * 1024 + (g * 4 + p) * HD + 16 * s + 8 * h);
#define NSA_ROW(lnv) ((size_t)b * SEQ + t0 + 32 * th + ((lnv) & 31))
#define NSA_GATE(k, lnv) sigmoidf_(bf2f(Y0[NSA_ROW(lnv) * LDY0 + YG + (g * 4 + p) * 3 + (k)]))
#define NSA_OROW(lnv) (MIXED + NSA_ROW(lnv) * DM + (g * 4 + p) * HD)
        f32x16 O[4]; f32x16 pp;
        const int nct = (4 * qc + 3 + 63) >> 6;
        const int chi = tq >= 31 ? (tq - 31) >> 4 : -1;
        float mA = -1e30f, lA = 0.f;
        nsa_issue(lds, KC, 256, VCT, 512, wave, lane);
        for (int it = 0; it < nct; ++it) {
            LAS unsigned char* buf = lds + (it & 1) * NSA_BUF;
            int ln = lane; asm volatile("" : "+v"(ln));
            NSA_SYNC();
            { const int cn = it + 1 < nct ? it + 1 : it + 1 - nct; nsa_issue(lds + ((it + 1) & 1) * NSA_BUF, KC + (size_t)cn * 64 * 256, 256, VCT + cn * 128, 512, wave, ln); }
#pragma unroll
            for (int hh = 0; hh < 2; ++hh) {
                nsa_scores(pp, buf, ln, Q, hh);
                nsa_mask(pp, it * 64 + 32 * hh + 4 * (ln >> 5), 0, chi);
                const float tm = tile_max(pp) * c2, mn = fmaxf(mA, tm); float rs = 0.f;
#pragma unroll
                for (int i = 0; i < 16; ++i) rs += __builtin_amdgcn_exp2f(fmaf(pp[i], c2, -mn));
                lA = lA * __builtin_amdgcn_exp2f(mA - mn) + half_sum(rs); mA = mn;
            }
        }
        NSA_ZERO_O();
        for (int it = nct; it < 2 * nct; ++it) {
            const int ct = it - nct; LAS unsigned char* buf = lds + (it & 1) * NSA_BUF;
            int ln = lane; asm volatile("" : "+v"(ln));
            NSA_SYNC();
            if (it + 1 < 2 * nct) { const int cn = it + 1 - nct; nsa_issue(lds + ((it + 1) & 1) * NSA_BUF, KC + (size_t)cn * 64 * 256, 256, VCT + cn * 128, 512, wave, ln); }
#pragma unroll
            for (int hh = 0; hh < 2; ++hh) {
                nsa_scores(pp, buf, ln, Q, hh);
                nsa_mask(pp, ct * 64 + 32 * hh + 4 * (ln >> 5), 0, chi);
                const float inv = lA > 0.f ? 1.f / lA : 0.f;
#pragma unroll
                for (int i = 0; i < 16; ++i) pp[i] = pp[i] > -1.0e38f ? __builtin_amdgcn_exp2f(fmaf(pp[i], c2, -mA)) * inv : 0.f;
                LAS unsigned* irow = imp + (32 * th + (ln & 31)) * 65 + ct * 16 + 8 * hh + (ln >> 5);
#pragma unroll
                for (int rg = 0; rg < 4; ++rg) {
                    const float s0 = (pp[4 * rg] + pp[4 * rg + 1]) + (pp[4 * rg + 2] + pp[4 * rg + 3]);
                    __hip_atomic_fetch_add(irow + 2 * rg, (unsigned)(s0 * 536870912.f + 0.5f), __ATOMIC_RELAXED, __HIP_MEMORY_SCOPE_WORKGROUP);
                    if (ct * 16 + 8 * hh + (ln >> 5) + 2 * rg + 1 < 64) __hip_atomic_fetch_add(irow + 2 * rg + 1, (unsigned)(pp[4 * rg + 3] * 536870912.f + 0.5f), __ATOMIC_RELAXED, __HIP_MEMORY_SCOPE_WORKGROUP);
                }
                nsa_pv(O, buf, ln, pp, hh);
            }
        }
        { int l2 = lane; asm volatile("" : "+v"(l2)); nsa_out<false>(NSA_OROW(l2), l2 >> 5, O, NSA_GATE(0, l2)); }
        NSA_SYNC();
#pragma unroll 1
        for (int tt = 0; tt < 8; ++tt) { const int t = wave * 8 + tt; const LAS unsigned* row = imp + t * 65;
            const bool forced = (lane == 0) || (lane == qc) || (lane == qc - 1); const unsigned v = forced ? 0xffffffffu : row[lane]; int rank = 0;
#pragma unroll 4
            for (int i = 0; i <= qc; ++i) { const unsigned vi = (unsigned)__builtin_amdgcn_readlane((int)v, i); rank += (vi > v || (vi == v && i < lane)) ? 1 : 0; }
            const unsigned long long mk = __ballot(lane <= qc && rank < 16); if (lane == 0) msk[t] = mk; }
        nsa_issue(lds, KS, 512, VST, (size_t)SEQ * 2, wave, lane);
        NSA_SYNC();
        const unsigned long long mymask = msk[32 * th + r];
        {
            float mS = -1e30f, lS = 0.f;
            NSA_ZERO_O();
            for (int j = 0; j <= qc; ++j) {
                int ln = lane; asm volatile("" : "+v"(ln));
                if (j > 0) NSA_SYNC();
                if (j < qc) nsa_issue(lds + ((j + 1) & 1) * NSA_BUF, KS + (size_t)(j + 1) * 64 * 512, 512, VST + (size_t)(j + 1) * 128, (size_t)SEQ * 2, wave, ln);
                const float bias = ((mymask >> j) & 1ull) ? 0.f : -1e30f;
#pragma unroll
                for (int hh = 0; hh < 2; ++hh) {
                    nsa_scores(pp, lds + (j & 1) * NSA_BUF, ln, Q, hh);
                    if (j == qc) nsa_mask(pp, j * 64 + 32 * hh + 4 * (ln >> 5), 0, t0 + 32 * th + (ln & 31));
                    nsa_step(pp, bias, c2, mS, lS, O, lds + (j & 1) * NSA_BUF, ln, hh);
                }
            }
            int l2 = lane; asm volatile("" : "+v"(l2)); nsa_out<true>(NSA_OROW(l2), l2 >> 5, O, NSA_GATE(1, l2) / lS);
        }
        {
            const int j0 = qc >= 8 ? qc - 8 : 0;
            NSA_SYNC();
            nsa_issue(lds + (j0 & 1) * NSA_BUF, KW + (size_t)j0 * 64 * 512, 512, VWT + (size_t)j0 * 128, (size_t)SEQ * 2, wave, lane);
            float mW = -1e30f, lW = 0.f;
            NSA_ZERO_O();
            for (int j = j0; j <= qc; ++j) {
                int ln = lane; asm volatile("" : "+v"(ln));
                NSA_SYNC();
                if (j < qc) nsa_issue(lds + ((j + 1) & 1) * NSA_BUF, KW + (size_t)(j + 1) * 64 * 512, 512, VWT + (size_t)(j + 1) * 128, (size_t)SEQ * 2, wave, ln);
#pragma unroll
                for (int hh = 0; hh < 2; ++hh) {
                    nsa_scores(pp, lds + (j & 1) * NSA_BUF, ln, Q, hh);
                    if (j == qc || j == qc - 8) { const int tql = t0 + 32 * th + (ln & 31); nsa_mask(pp, j * 64 + 32 * hh + 4 * (ln >> 5), tql - 511, tql); }
                    nsa_step(pp, 0.f, c2, mW, lW, O, lds + (j & 1) * NSA_BUF, ln, hh);
                }
            }
            int l2 = lane; asm volatile("" : "+v"(l2)); nsa_out<true>(NSA_OROW(l2), l2 >> 5, O, NSA_GATE(2, l2) / lW);
        }
    }
}

constexpr size_t MLG_A = WS_SB + 8 * MiB, MLG_P = MLG_A + 256 * 1024, MLG_AL = MLG_P + 256 * 1024, MLG_RS = MLG_AL + 256 * 1024, MLG_KBAR = WS_SB + 9 * MiB;
__device__ __forceinline__ void ph_ml_s(KArgs a, LAS unsigned char* lds, const Ctx& c) {
    unsigned char* ws = a.ws; const bf16* Y0 = (const bf16*)(ws + WS_Y0); const bf16* MQ = (const bf16*)(ws + WS_MQ); const bf16* MK = (const bf16*)(ws + WS_MK); bf16* SA = (bf16*)(ws + WS_SB);
    float* GA = (float*)(ws + MLG_A); float* GP = (float*)(ws + MLG_P); float* GAL = (float*)(ws + MLG_AL); float* GRS = (float*)(ws + MLG_RS); float* KBAR = (float*)(ws + MLG_KBAR);
    const int lane = c.lane, wave = c.wave, r = lane & 31, hf = lane >> 5, sub = wave >> 2, st = (wave >> 1) & 1, tt = wave & 1;
    LAS unsigned char* qT = lds + sub * 67584; LAS unsigned char* kT = qT + 33792;
    LAS float* alph = (LAS float*)(lds + MISC_OFF + 64) + sub * 128;
    for (int it = blockIdx.x; it < BATCH * ML_H * 32; it += gridDim.x) {
        const int u = 2 * it + sub, ch = u & 63, bh = u >> 6, h = bh & 3, b = bh >> 2; const size_t m0 = (size_t)b * SEQ + ch * 64;
        __syncthreads();
#pragma unroll
        for (int i = 0; i < 8; ++i) { const int idx = (c.tid & 255) + 256 * i, row = idx >> 5, q = idx & 31;
            *(LAS u32x4*)(qT + row * 528 + q * 16) = *(const u32x4*)(MQ + (m0 + row) * 1024 + h * 256 + q * 8);
            *(LAS u32x4*)(kT + row * 528 + q * 16) = *(const u32x4*)(MK + (m0 + row) * 1024 + h * 256 + q * 8); }
        if ((wave & 3) == 0) {
            const float ig = bf2f(Y0[(m0 + lane) * LDY0 + YI + h]); const float f = bf2f(Y0[(m0 + lane) * LDY0 + YF + h]) + a.in[I_FB][h];
            const float lf = fminf(f, 0.f) - log1pf(__expf(-fabsf(f)));
            float av = lf;
#pragma unroll
            for (int o = 1; o < 64; o <<= 1) { const float t2 = __shfl_up(av, o); if (lane >= o) av += t2; }
            const float uv = ig - av; float pmv = uv;
#pragma unroll
            for (int o = 1; o < 64; o <<= 1) { const float t2 = __shfl_up(pmv, o); if (lane >= o) pmv = fmaxf(pmv, t2); }
            const float al = __expf(uv - __shfl(pmv, 63));
            alph[lane] = al; alph[64 + lane] = 0.f;
            const size_t gi = (size_t)bh * SEQ + ch * 64 + lane; GA[gi] = av; GP[gi] = pmv; GAL[gi] = al;
        }
        __syncthreads();
        f32x16 acc;
#pragma unroll
        for (int i = 0; i < 16; ++i) acc[i] = 0.f;
        if (tt >= st) {
            const LAS unsigned char* ka = kT + (32 * st + r) * 528 + hf * 16; const LAS unsigned char* qa = qT + (32 * tt + r) * 528 + hf * 16;
#pragma unroll
            for (int ks = 0; ks < 16; ++ks) acc = __builtin_amdgcn_mfma_f32_32x32x16_bf16(*(const LAS bf16x8*)(ka + ks * 32), *(const LAS bf16x8*)(qa + ks * 32), acc, 0, 0, 0);
        }
        const int t = 32 * tt + r; float rsum = 0.f;
        bf16* srow = SA + (size_t)u * 4096 + t * 64 + 32 * st + 4 * hf;
#pragma unroll
        for (int q4 = 0; q4 < 4; ++q4) { const f32x4 al4 = *(const LAS f32x4*)(alph + 32 * st + 8 * q4 + 4 * hf); float v[4];
#pragma unroll
            for (int j = 0; j < 4; ++j) { const int s = 32 * st + 8 * q4 + 4 * hf + j; v[j] = t >= s ? acc[4 * q4 + j] * al4[j] : 0.f; }
            u32x2 o; o.x = pg8::cvt_pk_bf16(v[0], v[1]); o.y = pg8::cvt_pk_bf16(v[2], v[3]); *(u32x2*)(srow + 8 * q4) = o;
            rsum += (lo16(o.x) + hi16(o.x)) + (lo16(o.y) + hi16(o.y)); }
        rsum = half_sum(rsum);
        if (hf == 0 && tt >= st) __hip_atomic_fetch_add(alph + 64 + t, rsum, __ATOMIC_RELAXED, __HIP_MEMORY_SCOPE_WORKGROUP);
        { const int d = c.tid & 255; float kb = 0.f;
#pragma unroll 8
          for (int s = 0; s < 64; ++s) kb += alph[s] * bf2f(*(const LAS unsigned short*)(kT + s * 528 + d * 2));
          KBAR[(size_t)u * 256 + d] = kb; }
        __syncthreads();
        if ((wave & 3) == 0) GRS[(size_t)bh * SEQ + ch * 64 + lane] = alph[64 + lane];
    }
}
constexpr int MQ_Q = 0, MQ_K = 33792, MQ_V = MQ_K + 64 * 544, MQ_VZ = MQ_V + 4608, MQ_S = MQ_VZ + 4608, MQ_C = MQ_S + 9216, MQ_N = MQ_C + 16896, MQ_END = MQ_N + 1024;
constexpr int MQ_OUT = 106496;
constexpr int MQ_NB = MQ_OUT + 64 * 144;
constexpr int MQ_QN = MQ_NB + 512;
constexpr int MQ_OUT2 = MQ_QN + 256;
static_assert(MQ_END <= MQ_OUT && MQ_OUT2 + 64 * 144 <= MISC_OFF, "mLSTM LDS map");
template <int ROLE> __device__ __forceinline__ void ml_q_loop(LAS unsigned char* lds, int tid0, int wave, unsigned char* ws, int b, int h, int es, int bh) {
    asm volatile("" : "+v"(tid0));
    const bf16* Y0 = (const bf16*)(ws + WS_Y0); const bf16* MQ = (const bf16*)(ws + WS_MQ); const bf16* MK = (const bf16*)(ws + WS_MK); const bf16* SA = (const bf16*)(ws + WS_SB);
    const float* gbase = (const float*)(ws + MLG_A) + (size_t)bh * SEQ; const float* pbase = (const float*)(ws + MLG_P) + (size_t)bh * SEQ; const float* albase = (const float*)(ws + MLG_AL) + (size_t)bh * SEQ; const float* rsbase = (const float*)(ws + MLG_RS) + (size_t)bh * SEQ;
    float* HRAW = (float*)(ws + WS_HRAW);
    LAS float* nS = (LAS float*)(lds + MQ_N);
    const bf16* qsrc; const bf16* ksrc; const bf16* vsrc; const bf16* ssrc; const float* alsrc; const float* kbsrc; int tok0;
    {   const int tid = tid0, prow = tid >> 5, pq = tid & 31, vrow = tid >> 3, vq = tid & 7;
        qsrc = MQ + ((size_t)b * SEQ + prow) * 1024 + h * 256 + pq * 8; ksrc = MK + ((size_t)b * SEQ + prow) * 1024 + h * 256 + pq * 8;
        vsrc = Y0 + ((size_t)b * SEQ + (tid >> 2)) * LDY0 + YMV + h * 256 + es * 32 + (tid & 3) * 8; ssrc = SA + ((size_t)bh * 64) * 4096 + vrow * 64 + vq * 8;
        alsrc = albase + (tid >> 2); kbsrc = (const float*)(ws + MLG_KBAR) + (size_t)bh * 64 * 256 + (tid - 128);
        tok0 = 32 * (tid >> 6) + (tid & 31); }
    u32x4 pqv[2][4], pkv[2][4], pv[2], ps[2]; float pal[2], pmu[2], paL[2], gp[2], grs[2], ga[2], kb[2][2];
#define MLQ_LOAD(par, cn) do { const size_t adv = (size_t)(cn) * 64; \
        _Pragma("unroll") for (int i = 0; i < 4; ++i) { pqv[par][i] = *(const u32x4*)(qsrc + (adv + 16 * i) * 1024); pkv[par][i] = *(const u32x4*)(ksrc + (adv + 16 * i) * 1024); } \
        ps[par] = *(const u32x4*)(ssrc + (size_t)(cn) * 4096); pmu[par] = pbase[(cn) * 64 + 63]; paL[par] = gbase[(cn) * 64 + 63]; \
        if constexpr (ROLE != 2) { pv[par] = *(const u32x4*)(vsrc + adv * LDY0); pal[par] = alsrc[adv]; } \
        if constexpr (ROLE == 0) { gp[par] = pbase[adv + tok0]; grs[par] = rsbase[adv + tok0]; ga[par] = gbase[adv + tok0]; } \
        if constexpr (ROLE == 1) { kb[par][0] = kbsrc[(size_t)(cn) * 256]; kb[par][1] = kbsrc[(size_t)(cn) * 256 + 128]; } } while (0)
    MLQ_LOAD(0, 0); MLQ_LOAD(1, 1);
    f32x16 C2[2];
    if constexpr (ROLE == 2) {
#pragma unroll
        for (int k = 0; k < 2; ++k)
#pragma unroll
            for (int i = 0; i < 16; ++i) C2[k][i] = 0.f; }
    float mcar = 0.f;
    for (int ch2 = 0; ch2 < 64; ch2 += 2) {
#pragma unroll
      for (int par = 0; par < 2; ++par) { const int ch = ch2 + par;
        int tid = tid0; asm volatile("" : "+v"(tid));
        const int lane = tid & 63, r = lane & 31, hf = lane >> 5, prow = tid >> 5, pq = tid & 31, vrow = tid >> 3, vq = tid & 7;
        const float mu = pmu[par], aL = paL[par], mx = fmaxf(mcar, mu), decay = __expf(mcar - mx), delta = __expf(mu - mx);
#pragma unroll
        for (int i = 0; i < 4; ++i) { *(LAS u32x4*)(lds + MQ_Q + (prow + 16 * i) * 528 + pq * 16) = pqv[par][i]; *(LAS u32x4*)(lds + MQ_K + (prow + 16 * i) * 544 + pq * 16) = pkv[par][i]; }
        *(LAS u32x4*)(lds + MQ_S + vrow * 144 + vq * 16) = ps[par];
        if constexpr (ROLE != 2) { const float z = delta * pal[par]; const u32x4 pw = pv[par];
            { LAS u32x2* d8 = (LAS u32x2*)(lds + MQ_V + (tid >> 2) * 72 + (tid & 3) * 16); d8[0] = (u32x2){pw.x, pw.y}; d8[1] = (u32x2){pw.z, pw.w}; }
            u32x4 zv; zv.x = pg8::cvt_pk_bf16(lo16(pw.x) * z, hi16(pw.x) * z); zv.y = pg8::cvt_pk_bf16(lo16(pw.y) * z, hi16(pw.y) * z); zv.z = pg8::cvt_pk_bf16(lo16(pw.z) * z, hi16(pw.z) * z); zv.w = pg8::cvt_pk_bf16(lo16(pw.w) * z, hi16(pw.w) * z);
            { LAS u32x2* d8 = (LAS u32x2*)(lds + MQ_VZ + (tid >> 2) * 72 + (tid & 3) * 16); d8[0] = (u32x2){zv.x, zv.y}; d8[1] = (u32x2){zv.z, zv.w}; } }
        if constexpr (ROLE == 2) { if (ch > 0) {
            asm volatile("s_nop 15\n\ts_nop 7" : "+v"(C2[0]), "+v"(C2[1]));
#pragma unroll
            for (int k = 0; k < 2; ++k)
#pragma unroll
                for (int q4 = 0; q4 < 4; ++q4) { u32x2 o; o.x = pg8::cvt_pk_bf16(C2[k][4 * q4], C2[k][4 * q4 + 1]); o.y = pg8::cvt_pk_bf16(C2[k][4 * q4 + 2], C2[k][4 * q4 + 3]);
                    *(LAS u32x2*)(lds + MQ_C + r * 528 + (64 * (wave - 4) + 32 * k + 8 * q4 + 4 * hf) * 2) = o; } } }
        const float gpc = gp[par], grsc = grs[par], gac = ga[par], kbc0 = kb[par][0], kbc1 = kb[par][1];
        LDS_BARRIER();
        { const int cn = ch + 2 < 64 ? ch + 2 : 63; MLQ_LOAD(par, cn); }
        f32x16 cr, in; float et = 0.f, bt = 0.f, eexp = 0.f;
        if constexpr (ROLE == 0) {
            const int tt = wave;
#pragma unroll
            for (int i = 0; i < 16; ++i) { cr[i] = 0.f; in[i] = 0.f; }
            const LAS unsigned char* ca = lds + MQ_C + r * 528 + hf * 16; const LAS unsigned char* qa = lds + MQ_Q + (32 * tt + r) * 528 + hf * 16;
            const int il = lane & 15, g = lane >> 4;
            const LAS unsigned char* va = lds + MQ_V + (8 * (g >> 1) + (il >> 2)) * 72 + (16 * (g & 1) + 4 * (il & 3)) * 2;
            const LAS unsigned char* sa = lds + MQ_S + (32 * tt + r) * 144 + hf * 16;
            bf16x8 fc[2][4], fq[2][4], iv[4], is[4];
#pragma unroll
            for (int j = 0; j < 4; ++j) { fc[0][j] = *(const LAS bf16x8*)(ca + j * 32); fq[0][j] = *(const LAS bf16x8*)(qa + j * 32); }
#pragma unroll
            for (int gq = 0; gq < 4; ++gq) {
                if (gq < 3) {
#pragma unroll
                    for (int j = 0; j < 4; ++j) { const int ks = 4 * (gq + 1) + j; fc[(gq + 1) & 1][j] = *(const LAS bf16x8*)(ca + ks * 32); fq[(gq + 1) & 1][j] = *(const LAS bf16x8*)(qa + ks * 32); }
                } else {
#pragma unroll
                    for (int ks = 0; ks < 4; ++ks) { const s16x4 lo = lds_tr16(va + ks * 16 * 72), hi = lds_tr16(va + ks * 16 * 72 + 4 * 72);
                        iv[ks] = (bf16x8){lo[0], lo[1], lo[2], lo[3], hi[0], hi[1], hi[2], hi[3]}; is[ks] = *(const LAS bf16x8*)(sa + ks * 32); }
                }
#pragma unroll
                for (int j = 0; j < 4; ++j) cr = __builtin_amdgcn_mfma_f32_32x32x16_bf16(fc[gq & 1][j], fq[gq & 1][j], cr, 0, 0, 0);
                asm volatile("" : "+v"(cr) :: "memory");
            }
#pragma unroll
            for (int ks = 0; ks < 4; ++ks) in = __builtin_amdgcn_mfma_f32_32x32x16_bf16(iv[ks], is[ks], in, 0, 0, 0);
            const float Mt = fmaxf(mcar, gpc); et = __expf(mcar - Mt); bt = __expf(mu - Mt); eexp = __expf(-(gac + Mt));
        }
        if constexpr (ROLE == 1) {
            const int tt = wave - 2;
            f32x16 cn;
#pragma unroll
            for (int i = 0; i < 16; ++i) cn[i] = 0.f;
            const LAS unsigned char* qa = lds + MQ_Q + (32 * tt + r) * 528 + hf * 16; const LAS unsigned char* na = lds + MQ_NB + hf * 16;
            bf16x8 fq[2][4], fn[2][4];
#pragma unroll
            for (int j = 0; j < 4; ++j) { fq[0][j] = *(const LAS bf16x8*)(qa + j * 32); fn[0][j] = *(const LAS bf16x8*)(na + j * 32); }
#pragma unroll
            for (int gq = 0; gq < 4; ++gq) {
                if (gq < 3) {
#pragma unroll
                    for (int j = 0; j < 4; ++j) { const int ks = 4 * (gq + 1) + j; fq[(gq + 1) & 1][j] = *(const LAS bf16x8*)(qa + ks * 32); fn[(gq + 1) & 1][j] = *(const LAS bf16x8*)(na + ks * 32); }
                }
#pragma unroll
                for (int j = 0; j < 4; ++j) cn = __builtin_amdgcn_mfma_f32_32x32x16_bf16(fn[gq & 1][j], fq[gq & 1][j], cn, 0, 0, 0);
                asm volatile("" : "+v"(cn) :: "memory");
            }
            if (hf == 0) *(LAS float*)(lds + MQ_QN + (32 * tt + r) * 4) = cn[0];
        }
        if constexpr (ROLE == 2) {
            const int il = lane & 15, g = lane >> 4, d0 = 64 * (wave - 4);
#pragma unroll
            for (int k = 0; k < 2; ++k)
#pragma unroll
                for (int i = 0; i < 16; ++i) C2[k][i] *= decay;
            const LAS unsigned char* kbase = lds + MQ_K + (8 * (g >> 1) + (il >> 2)) * 544 + (d0 + 16 * (g & 1) + 4 * (il & 3)) * 2;
            const LAS unsigned char* vbase = lds + MQ_VZ + (8 * (g >> 1) + (il >> 2)) * 72 + (16 * (g & 1) + 4 * (il & 3)) * 2;
#pragma unroll
            for (int ks = 0; ks < 4; ++ks) {
                const s16x4 lo2 = lds_tr16(vbase + ks * 16 * 72), hi2 = lds_tr16(vbase + ks * 16 * 72 + 4 * 72); const bf16x8 vb = (bf16x8){lo2[0], lo2[1], lo2[2], lo2[3], hi2[0], hi2[1], hi2[2], hi2[3]};
#pragma unroll
                for (int k = 0; k < 2; ++k) { const s16x4 lo = lds_tr16(kbase + ks * 16 * 544 + k * 64), hi = lds_tr16(kbase + ks * 16 * 544 + 4 * 544 + k * 64);
                    C2[k] = __builtin_amdgcn_mfma_f32_32x32x16_bf16((bf16x8){lo[0], lo[1], lo[2], lo[3], hi[0], hi[1], hi[2], hi[3]}, vb, C2[k], 0, 0, 0); }
            }
        }
        LDS_BARRIER();
        {
            const int cf = ch > 0 ? ch - 1 : 0; const u32x4 ov = *(const LAS u32x4*)(lds + (par ? MQ_OUT : MQ_OUT2) + (tid >> 3) * 144 + (tid & 7) * 16);
            *(u32x4*)(HRAW + ((size_t)b * SEQ + cf * 64 + (tid >> 3)) * 1024 + h * 256 + es * 32 + (tid & 7) * 4) = ov; }
        if constexpr (ROLE == 0) {
            const int tt = wave; const float qn = *(const LAS float*)(lds + MQ_QN + (32 * tt + r) * 4);
            const float den = et * qn + bt * grsc, inv = 1.f / fmaxf(fabsf(den), eexp);
            LAS unsigned char* orow = lds + (par ? MQ_OUT2 : MQ_OUT) + (32 * tt + r) * 144 + 16 * hf;
#pragma unroll
            for (int q4 = 0; q4 < 4; ++q4) { f32x4 o; o.x = (et * cr[4 * q4] + bt * in[4 * q4]) * inv; o.y = (et * cr[4 * q4 + 1] + bt * in[4 * q4 + 1]) * inv; o.z = (et * cr[4 * q4 + 2] + bt * in[4 * q4 + 2]) * inv; o.w = (et * cr[4 * q4 + 3] + bt * in[4 * q4 + 3]) * inv;
                *(LAS f32x4*)(orow + 32 * q4) = o; } }
        if constexpr (ROLE == 1) { const int d = tid - 128; const float n0 = decay * nS[d] + delta * kbc0, n1 = decay * nS[d + 128] + delta * kbc1; nS[d] = n0; nS[d + 128] = n1;
            *(LAS unsigned short*)(lds + MQ_NB + d * 2) = (unsigned short)(pg8::cvt_pk_bf16(n0, n0) & 0xffffu); *(LAS unsigned short*)(lds + MQ_NB + (d + 128) * 2) = (unsigned short)(pg8::cvt_pk_bf16(n1, n1) & 0xffffu); }
        mcar = aL + mx;
      }
    }
    LDS_BARRIER();
    { const u32x4 ov = *(const LAS u32x4*)(lds + MQ_OUT2 + (tid0 >> 3) * 144 + (tid0 & 7) * 16); *(u32x4*)(HRAW + ((size_t)b * SEQ + 63 * 64 + (tid0 >> 3)) * 1024 + h * 256 + es * 32 + (tid0 & 7) * 4) = ov; }
#undef MLQ_LOAD
}
__device__ __forceinline__ void ph_ml_q(KArgs a, LAS unsigned char* lds, const Ctx& c) {
    unsigned char* ws = a.ws;
    const int tid0 = c.tid, wave = c.wave;
    LAS float* nS = (LAS float*)(lds + MQ_N);
    for (int u = blockIdx.x; u < 128; u += gridDim.x) {
        const int bh = (u & 7) * 2 + (u >> 6), es = (u >> 3) & 7, h = bh & 3, b = bh >> 2;
        __syncthreads();
        for (int i = tid0; i < 16896 / 4; i += NTHR) ((LAS unsigned*)(lds + MQ_C))[i] = 0u;
        if (tid0 < 256) nS[tid0] = 0.f;
        if (tid0 < 128) ((LAS unsigned*)(lds + MQ_NB))[tid0] = 0u;
        if (wave < 2) ml_q_loop<0>(lds, tid0, wave, ws, b, h, es, bh);
        else if (wave < 4) ml_q_loop<1>(lds, tid0, wave, ws, b, h, es, bh);
        else ml_q_loop<2>(lds, tid0, wave, ws, b, h, es, bh);
    }
}

__device__ __forceinline__ void ph_mlstm_post(KArgs a, const Ctx& c) {
    unsigned char* ws = a.ws; const bf16* Y0 = (const bf16*)(ws + WS_Y0); const float* HRAW = (const float*)(ws + WS_HRAW); bf16* MIXED = (bf16*)(ws + WS_MIXED);
    for (int m = c.gw; m < MTOK; m += c.ngw) {
        f32x4 v[4], g[4]; u32x2 ow[4];
#pragma unroll
        for (int h = 0; h < 4; ++h) { const int col = h * 256 + c.lane * 4; v[h] = *(const f32x4*)(HRAW + (size_t)m * 1024 + col); g[h] = *(const f32x4*)(a.in[I_MNORM] + col); ow[h] = *(const u32x2*)(Y0 + (size_t)m * LDY0 + YMO + col); }
#pragma unroll
        for (int h = 0; h < 4; ++h) { const int col = h * 256 + c.lane * 4;
            const float r = rsqrtf(wave_sum((v[h].x * v[h].x + v[h].y * v[h].y) + (v[h].z * v[h].z + v[h].w * v[h].w)) * (1.f / 256.f) + RMS_EPS);
            u32x2 o; o.x = pk2(v[h].x * r * g[h].x * sigmoidf_(lo16(ow[h].x)), v[h].y * r * g[h].y * sigmoidf_(hi16(ow[h].x))); o.y = pk2(v[h].z * r * g[h].z * sigmoidf_(lo16(ow[h].y)), v[h].w * r * g[h].w * sigmoidf_(hi16(ow[h].y)));
            *(u32x2*)(MIXED + (size_t)m * DM + 1024 + col) = o; }
    }
}

__device__ __forceinline__ void ph_ret_s(KArgs a, LAS unsigned char* lds, const Ctx& c) {
    unsigned char* ws = a.ws; const bf16* QR = (const bf16*)(ws + WS_Y1); const bf16* KR = (const bf16*)(ws + WS_Y1) + 2048; bf16* SR = (bf16*)(ws + WS_SR);
    const int lane = c.lane, wave = c.wave, r = lane & 31, hf = lane >> 5, sub = wave >> 2, st = (wave >> 1) & 1, tt = wave & 1;
    LAS unsigned char* qT = lds + sub * 67584; LAS unsigned char* kT = qT + 33792;
    for (int it = blockIdx.x; it < BATCH * RT_H * 32; it += gridDim.x) {
        const int u = 2 * it + sub, ch = u & 63, bh = u >> 6, h = bh & 7, b = bh >> 3; const size_t m0 = (size_t)b * SEQ + ch * 64;
        __syncthreads();
#pragma unroll
        for (int i = 0; i < 8; ++i) { const int idx = (c.tid & 255) + 256 * i, row = idx >> 5, q = idx & 31;
            *(LAS u32x4*)(qT + row * 528 + q * 16) = *(const u32x4*)(QR + (m0 + row) * LDY1 + h * 256 + q * 8);
            *(LAS u32x4*)(kT + row * 528 + q * 16) = *(const u32x4*)(KR + (m0 + row) * LDY1 + h * 256 + q * 8); }
        __syncthreads();
        f32x16 acc;
#pragma unroll
        for (int i = 0; i < 16; ++i) acc[i] = 0.f;
        if (tt >= st) {
            const LAS unsigned char* ka = kT + (32 * st + r) * 528 + hf * 16; const LAS unsigned char* qa = qT + (32 * tt + r) * 528 + hf * 16;
#pragma unroll
            for (int ks = 0; ks < 16; ++ks) acc = __builtin_amdgcn_mfma_f32_32x32x16_bf16(*(const LAS bf16x8*)(ka + ks * 32), *(const LAS bf16x8*)(qa + ks * 32), acc, 0, 0, 0);
        }
        const float l2g = log2f(1.f - exp2f(-5.f - (float)h)); const int t = 32 * tt + r;
        bf16* srow = SR + (size_t)u * 4096 + t * 64 + 32 * st + 4 * hf;
#pragma unroll
        for (int q4 = 0; q4 < 4; ++q4) { float v[4];
#pragma unroll
            for (int j = 0; j < 4; ++j) { const int s = 32 * st + 8 * q4 + 4 * hf + j; v[j] = t >= s ? acc[4 * q4 + j] * __builtin_amdgcn_exp2f((float)(t - s) * l2g) : 0.f; }
            u32x2 o; o.x = pg8::cvt_pk_bf16(v[0], v[1]); o.y = pg8::cvt_pk_bf16(v[2], v[3]); *(u32x2*)(srow + 8 * q4) = o; }
    }
}

constexpr int RQ_Q = 0, RQ_K = 33792, RQ_V = RQ_K + 64 * 544, RQ_VZ = RQ_V + 9216, RQ_S = RQ_VZ + 9216, RQ_R = RQ_S + 9216, RQ_END = RQ_R + 33792;
static_assert(RQ_END <= MISC_OFF, "retention LDS map");
template <bool CONS> __device__ __forceinline__ void ret_q_loop(LAS unsigned char* lds, int tid0, int wave, const bf16* Y1, const bf16* SR, bf16* YRET, int b, int h, int es, int bh) {
    asm volatile("" : "+v"(tid0));
    const float l2g = log2f(1.f - exp2f(-5.f - (float)h)), cd = __builtin_amdgcn_exp2f(64.f * l2g);
    const bf16* qsrc; const bf16* ksrc; const bf16* vsrc; const bf16* ssrc; float zeta;
    {
        const int tid = tid0, prow = tid >> 5, pq = tid & 31, vrow = (tid >> 3) & 31, vq = tid & 7;
        zeta = __builtin_amdgcn_exp2f((float)(63 - vrow) * l2g);
        qsrc = Y1 + ((size_t)b * SEQ + prow) * LDY1 + h * 256 + pq * 8; ksrc = qsrc + 2048;
        vsrc = Y1 + ((size_t)b * SEQ + vrow) * LDY1 + 4096 + h * 512 + es * 64 + vq * 8; ssrc = SR + ((size_t)bh * 64) * 4096 + vrow * 64 + vq * 8; }
    bf16* obase = YRET + ((size_t)b * SEQ) * 4096 + h * 512 + es * 64;
    const float zeta2 = zeta * __builtin_amdgcn_exp2f(-32.f * l2g);
    u32x4 pqv[2][4], pkv[2][4], pv[2][2], ps[2][2];
#pragma unroll
    for (int par = 0; par < 2; ++par) {
#pragma unroll
        for (int i = 0; i < 4; ++i) { pqv[par][i] = *(const u32x4*)(qsrc + (size_t)(64 * par + 16 * i) * LDY1); pkv[par][i] = *(const u32x4*)(ksrc + (size_t)(64 * par + 16 * i) * LDY1); }
        if constexpr (CONS) {
#pragma unroll
            for (int i = 0; i < 2; ++i) { pv[par][i] = *(const u32x4*)(vsrc + (size_t)(64 * par + 32 * i) * LDY1); ps[par][i] = *(const u32x4*)(ssrc + (size_t)par * 4096 + 32 * i * 64); } } }
    f32x16 R[4];
    if constexpr (!CONS) {
#pragma unroll
        for (int k = 0; k < 4; ++k)
#pragma unroll
            for (int i = 0; i < 16; ++i) R[k][i] = 0.f; }
    for (int ch2 = 0; ch2 < 64; ch2 += 2) {
#pragma unroll
      for (int par = 0; par < 2; ++par) { const int ch = ch2 + par;
        int tid = tid0; asm volatile("" : "+v"(tid));
        const int lane = tid & 63, r = lane & 31, hf = lane >> 5, prow = tid >> 5, pq = tid & 31, vrow = tid >> 3, vq = tid & 7;
#pragma unroll
        for (int i = 0; i < 4; ++i) { *(LAS u32x4*)(lds + RQ_Q + (prow + 16 * i) * 528 + pq * 16) = pqv[par][i]; *(LAS u32x4*)(lds + RQ_K + (prow + 16 * i) * 544 + pq * 16) = pkv[par][i]; }
        if constexpr (CONS) {
#pragma unroll
          for (int i2 = 0; i2 < 2; ++i2) { const int vr = (vrow & 31) + 32 * i2; const float zz = i2 ? zeta2 : zeta;
        *(LAS u32x4*)(lds + RQ_V + vr * 144 + vq * 16) = pv[par][i2]; *(LAS u32x4*)(lds + RQ_S + vr * 144 + vq * 16) = ps[par][i2];
        { const u32x4 pw = pv[par][i2]; u32x4 z; z.x = pg8::cvt_pk_bf16(lo16(pw.x) * zz, hi16(pw.x) * zz); z.y = pg8::cvt_pk_bf16(lo16(pw.y) * zz, hi16(pw.y) * zz); z.z = pg8::cvt_pk_bf16(lo16(pw.z) * zz, hi16(pw.z) * zz); z.w = pg8::cvt_pk_bf16(lo16(pw.w) * zz, hi16(pw.w) * zz);
          *(LAS u32x4*)(lds + RQ_VZ + vr * 144 + vq * 16) = z; } } }
        if constexpr (!CONS) { if (ch > 0) {
            asm volatile("s_nop 15\n\ts_nop 7" : "+v"(R[0]), "+v"(R[1]), "+v"(R[2]), "+v"(R[3]));
#pragma unroll
            for (int k = 0; k < 4; ++k) { const int dtl = k >> 1, et = k & 1;
#pragma unroll
                for (int q4 = 0; q4 < 4; ++q4) { u32x2 o; o.x = pg8::cvt_pk_bf16(R[k][4 * q4], R[k][4 * q4 + 1]); o.y = pg8::cvt_pk_bf16(R[k][4 * q4 + 2], R[k][4 * q4 + 3]);
                    *(LAS u32x2*)(lds + RQ_R + (32 * et + r) * 528 + (64 * (wave - 4) + 32 * dtl + 8 * q4 + 4 * hf) * 2) = o; } } } }
        LDS_BARRIER();
        {
            const int cn = ch + 2 < 64 ? ch + 2 : 63; const size_t adv = (size_t)cn * 64;
#pragma unroll
            for (int i = 0; i < 4; ++i) { pqv[par][i] = *(const u32x4*)(qsrc + (adv + 16 * i) * LDY1); pkv[par][i] = *(const u32x4*)(ksrc + (adv + 16 * i) * LDY1); }
            if constexpr (CONS) {
#pragma unroll
                for (int i = 0; i < 2; ++i) { pv[par][i] = *(const u32x4*)(vsrc + (adv + 32 * i) * LDY1); ps[par][i] = *(const u32x4*)(ssrc + (size_t)cn * 4096 + 32 * i * 64); } } }
        if constexpr (CONS) {
            const int et = wave >> 1, tt = wave & 1;
            f32x16 cr, in;
#pragma unroll
            for (int i = 0; i < 16; ++i) { cr[i] = 0.f; in[i] = 0.f; }
            const LAS unsigned char* ra = lds + RQ_R + (32 * et + r) * 528 + hf * 16; const LAS unsigned char* qa = lds + RQ_Q + (32 * tt + r) * 528 + hf * 16;
#pragma unroll
            for (int ks = 0; ks < 16; ++ks) { cr = __builtin_amdgcn_mfma_f32_32x32x16_bf16(*(const LAS bf16x8*)(ra + ks * 32), *(const LAS bf16x8*)(qa + ks * 32), cr, 0, 0, 0); if ((ks & 3) == 3) asm volatile("" : "+v"(cr) :: "memory"); }
            const int il = lane & 15, g = lane >> 4;
            const LAS unsigned char* va = lds + RQ_V + (8 * (g >> 1) + (il >> 2)) * 144 + (32 * et + 16 * (g & 1) + 4 * (il & 3)) * 2;
            const LAS unsigned char* sa = lds + RQ_S + (32 * tt + r) * 144 + hf * 16;
#pragma unroll
            for (int ks = 0; ks < 4; ++ks) { const s16x4 lo = lds_tr16(va + ks * 16 * 144), hi = lds_tr16(va + ks * 16 * 144 + 4 * 144);
                const bf16x8 av = (bf16x8){lo[0], lo[1], lo[2], lo[3], hi[0], hi[1], hi[2], hi[3]};
                in = __builtin_amdgcn_mfma_f32_32x32x16_bf16(av, *(const LAS bf16x8*)(sa + ks * 32), in, 0, 0, 0); }
            const float xi = __builtin_amdgcn_exp2f((float)(32 * tt + r + 1) * l2g);
            LAS unsigned char* orow = lds + RQ_OUT + (32 * tt + r) * 144 + (32 * et + 4 * hf) * 2;
#pragma unroll
            for (int q4 = 0; q4 < 4; ++q4) { u32x2 o; o.x = pg8::cvt_pk_bf16(in[4 * q4] + cr[4 * q4] * xi, in[4 * q4 + 1] + cr[4 * q4 + 1] * xi); o.y = pg8::cvt_pk_bf16(in[4 * q4 + 2] + cr[4 * q4 + 2] * xi, in[4 * q4 + 3] + cr[4 * q4 + 3] * xi);
                *(LAS u32x2*)(orow + 16 * q4) = o; }
        } else {
            const int il = lane & 15, g = lane >> 4, d0 = 64 * (wave - 4);
#pragma unroll
            for (int k = 0; k < 4; ++k)
#pragma unroll
                for (int i = 0; i < 16; ++i) R[k][i] *= cd;
            const LAS unsigned char* kbase = lds + RQ_K + (8 * (g >> 1) + (il >> 2)) * 544 + (d0 + 16 * (g & 1) + 4 * (il & 3)) * 2;
            const LAS unsigned char* vbase = lds + RQ_VZ + (8 * (g >> 1) + (il >> 2)) * 144 + (16 * (g & 1) + 4 * (il & 3)) * 2;
#pragma unroll
            for (int ks = 0; ks < 4; ++ks) {
                bf16x8 ka[2], vb[2];
#pragma unroll
                for (int x = 0; x < 2; ++x) { const s16x4 lo = lds_tr16(kbase + ks * 16 * 544 + x * 64), hi = lds_tr16(kbase + ks * 16 * 544 + 4 * 544 + x * 64); ka[x] = (bf16x8){lo[0], lo[1], lo[2], lo[3], hi[0], hi[1], hi[2], hi[3]};
                    const s16x4 lo2 = lds_tr16(vbase + ks * 16 * 144 + x * 64), hi2 = lds_tr16(vbase + ks * 16 * 144 + 4 * 144 + x * 64); vb[x] = (bf16x8){lo2[0], lo2[1], lo2[2], lo2[3], hi2[0], hi2[1], hi2[2], hi2[3]}; }
#pragma unroll
                for (int k = 0; k < 4; ++k) R[k] = __builtin_amdgcn_mfma_f32_32x32x16_bf16(ka[k >> 1], vb[k & 1], R[k], 0, 0, 0);
            }
        }
        LDS_BARRIER();
        { const u32x4 ov = *(const LAS u32x4*)(lds + RQ_OUT + (tid >> 3) * 144 + (tid & 7) * 16); *(u32x4*)(obase + ((size_t)(ch * 64 + (tid >> 3))) * 4096 + (tid & 7) * 8) = ov; }
      }
    }
}
__device__ __forceinline__ void ph_ret_q(KArgs a, LAS unsigned char* lds, const Ctx& c) {
    unsigned char* ws = a.ws; const bf16* Y1 = (const bf16*)(ws + WS_Y1); const bf16* SR = (const bf16*)(ws + WS_SR); bf16* YRET = (bf16*)(ws + WS_YRET);
    const int tid0 = c.tid, wave = c.wave;
    for (int u = blockIdx.x; u < 256; u += gridDim.x) {
        const int bh = (u & 7) * 4 + (u >> 6), es = (u >> 3) & 7, h = bh & 7, b = bh >> 3;
        __syncthreads();
        for (int i = tid0; i < 33792 / 4; i += NTHR) ((LAS unsigned*)(lds + RQ_R))[i] = 0u;
        if (wave < 4) ret_q_loop<true>(lds, tid0, wave, Y1, SR, YRET, b, h, es, bh);
        else ret_q_loop<false>(lds, tid0, wave, Y1, SR, YRET, b, h, es, bh);
    }
}

__device__ __forceinline__ void ph_ret_post(KArgs a, const Ctx& c) {
    unsigned char* ws = a.ws; const bf16* Y1 = (const bf16*)(ws + WS_Y1); bf16* YRET = (bf16*)(ws + WS_YRET);
    for (int m = c.gw; m < MTOK; m += c.ngw) {
        int ln = c.lane; asm volatile("" : "+v"(ln));
        u32x4 wv[8], gwv[8];
#pragma unroll
        for (int h = 0; h < 8; ++h) { const int col = h * 512 + ln * 8; wv[h] = *(const u32x4*)(YRET + (size_t)m * 4096 + col); gwv[h] = *(const u32x4*)(Y1 + (size_t)m * LDY1 + 8192 + col); }
#pragma unroll
        for (int h = 0; h < 8; ++h) { const int col = h * 512 + ln * 8; const u32x4 w = wv[h], gw = gwv[h];
            float v[8] = {lo16(w.x), hi16(w.x), lo16(w.y), hi16(w.y), lo16(w.z), hi16(w.z), lo16(w.w), hi16(w.w)};
            const float gg[8] = {lo16(gw.x), hi16(gw.x), lo16(gw.y), hi16(gw.y), lo16(gw.z), hi16(gw.z), lo16(gw.w), hi16(gw.w)};
            float ss = 0.f;
#pragma unroll
            for (int i = 0; i < 8; ++i) ss += v[i] * v[i];
            const float r = rsqrtf(wave_sum(ss) * (1.f / 512.f) + RMS_EPS);
            const f32x4 g0 = *(const f32x4*)(a.in[I_RNORM] + col), g1 = *(const f32x4*)(a.in[I_RNORM] + col + 4);
            const float gn[8] = {g0.x, g0.y, g0.z, g0.w, g1.x, g1.y, g1.z, g1.w};
#pragma unroll
            for (int i = 0; i < 8; ++i) v[i] = v[i] * r * gn[i] * siluf_(gg[i]);
            u32x4 o; o.x = pk2(v[0], v[1]); o.y = pk2(v[2], v[3]); o.z = pk2(v[4], v[5]); o.w = pk2(v[6], v[7]);
            *(u32x4*)(YRET + (size_t)m * 4096 + col) = o; }
    }
}

constexpr int MS_WGCNT = 768 * 1024;
__device__ __forceinline__ void ph_route(KArgs a, LAS unsigned char* lds, const Ctx& c) {
    unsigned char* ws = a.ws; const bf16* X3 = (const bf16*)(ws + WS_H); float* rstd = (float*)(ws + WS_MISC + MS_RSTD);
    int* toke = (int*)(ws + WS_MISC + MS_TOKE); float* tokg = (float*)(ws + WS_MISC + MS_TOKG); int* tokd = (int*)(ws + WS_MISC + MS_TOKD); unsigned* wgcnt = (unsigned*)(ws + WS_MISC + MS_WGCNT);
    const float* gain = a.in[I_NFO]; const float* wr = a.in[I_WR]; const int lane = c.lane;
    LAS unsigned* lcnt = (LAS unsigned*)lds;
    for (int w = blockIdx.x; w < MTOK / 64; w += gridDim.x) {
        __syncthreads();
        if (c.tid < 8) lcnt[c.tid] = 0u;
        __syncthreads();
#pragma unroll 1
        for (int k8 = 0; k8 < 8; ++k8) {
            const int m = w * 64 + c.wave * 8 + k8;
            const u32x4* xr = (const u32x4*)(X3 + (size_t)m * DM) + lane;
            u32x4 xv[4]; float s = 0.f;
#pragma unroll
            for (int j = 0; j < 4; ++j) { xv[j] = xr[64 * j]; const float e0 = lo16(xv[j].x), e1 = hi16(xv[j].x), e2 = lo16(xv[j].y), e3 = hi16(xv[j].y), e4 = lo16(xv[j].z), e5 = hi16(xv[j].z), e6 = lo16(xv[j].w), e7 = hi16(xv[j].w);
                s += ((e0 * e0 + e1 * e1) + (e2 * e2 + e3 * e3)) + ((e4 * e4 + e5 * e5) + (e6 * e6 + e7 * e7)); }
            const float r = rsqrtf(wave_sum(s) * (1.f / DM) + RMS_EPS);
            float lg[8];
#pragma unroll
            for (int e = 0; e < 8; ++e) lg[e] = 0.f;
#pragma unroll 2
            for (int j = 0; j < 4; ++j) { const int k0 = 8 * (64 * j + lane); const f32x4 ga = *(const f32x4*)(gain + k0), gb = *(const f32x4*)(gain + k0 + 4);
                const float y[8] = {lo16(xv[j].x) * r * ga.x, hi16(xv[j].x) * r * ga.y, lo16(xv[j].y) * r * ga.z, hi16(xv[j].y) * r * ga.w, lo16(xv[j].z) * r * gb.x, hi16(xv[j].z) * r * gb.y, lo16(xv[j].w) * r * gb.z, hi16(xv[j].w) * r * gb.w};
                const f32x4* w0 = (const f32x4*)(wr + (size_t)k0 * 8);
#pragma unroll
                for (int i = 0; i < 8; ++i) { const f32x4 wa = w0[2 * i], wb = w0[2 * i + 1];
                    lg[0] += y[i] * wa.x; lg[1] += y[i] * wa.y; lg[2] += y[i] * wa.z; lg[3] += y[i] * wa.w; lg[4] += y[i] * wb.x; lg[5] += y[i] * wb.y; lg[6] += y[i] * wb.z; lg[7] += y[i] * wb.w; } }
#pragma unroll
            for (int e = 0; e < 8; ++e) lg[e] = wave_sum(lg[e]);
            int i0 = 0; float v0 = lg[0];
#pragma unroll
            for (int e = 1; e < 8; ++e) if (lg[e] > v0) { v0 = lg[e]; i0 = e; }
            int i1 = -1; float v1 = -3.0e38f;
#pragma unroll
            for (int e = 0; e < 8; ++e) if (e != i0 && lg[e] > v1) { v1 = lg[e]; i1 = e; }
            if (lane == 0) { rstd[m] = r; const float g1 = 1.f / (1.f + __expf(v0 - v1)), g0 = 1.f - g1; toke[2 * m] = i0; toke[2 * m + 1] = i1; tokg[2 * m] = g0; tokg[2 * m + 1] = g1;
                tokd[2 * m] = (int)__hip_atomic_fetch_add(lcnt + i0, 1u, __ATOMIC_RELAXED, __HIP_MEMORY_SCOPE_WORKGROUP);
                tokd[2 * m + 1] = (int)__hip_atomic_fetch_add(lcnt + i1, 1u, __ATOMIC_RELAXED, __HIP_MEMORY_SCOPE_WORKGROUP); }
        }
        __syncthreads();
        if (c.tid < 8) wgcnt[w * 8 + c.tid] = lcnt[c.tid];
    }
}
__device__ __forceinline__ void ph_dispatch(KArgs a, LAS unsigned char* lds, const Ctx& c) {
    unsigned char* ws = a.ws; unsigned* ctl = (unsigned*)(ws + WS_CTL); const bf16* H = (const bf16*)(ws + WS_H); unsigned char* XBM = ws + WS_XBM;
    const int* toke = (const int*)(ws + WS_MISC + MS_TOKE); int* tokd = (int*)(ws + WS_MISC + MS_TOKD); const unsigned* wgcnt = (const unsigned*)(ws + WS_MISC + MS_WGCNT);
    LAS unsigned* tot = (LAS unsigned*)lds;
    __syncthreads();
    if (c.tid < 24) tot[c.tid] = 0u;
    __syncthreads();
    { const int e = c.tid & 7, part = c.tid >> 3; unsigned sacc = 0;
#pragma unroll
      for (int k = 0; k < 4; ++k) sacc += wgcnt[(part * 4 + k) * 8 + e];
      __hip_atomic_fetch_add(tot + e, sacc, __ATOMIC_RELAXED, __HIP_MEMORY_SCOPE_WORKGROUP); }
    __syncthreads();
    unsigned cnt[8], pst[8]; unsigned run = 0;
#pragma unroll
    for (int e = 0; e < 8; ++e) { cnt[e] = tot[e]; pst[e] = run; run += (cnt[e] + 255u) & ~255u; }
    if (c.gw == 0) {
        for (int pm = c.lane; pm < (int)(run >> 8); pm += 64) { unsigned e = 0;
#pragma unroll
            for (int q = 1; q < 8; ++q) if ((unsigned)pm * 256u >= pst[q]) e = q;
            ctl[CW_BLKE + pm] = e; }
        if (c.lane == 0) ctl[CW_NBLK] = run >> 8;
        if (c.lane < 8) { unsigned v = 0;
#pragma unroll
            for (int q = 0; q < 8; ++q) if (q == c.lane) v = pst[q] >> 8;
            ctl[CW_PST + c.lane] = v; }
    }
    for (int w = blockIdx.x; w < MTOK / 64; w += gridDim.x) {
        __syncthreads();
        if (c.tid < 8) tot[16 + c.tid] = 0u;
        __syncthreads();
        { const int e = c.tid & 7, part = c.tid >> 3; unsigned sacc = 0;
#pragma unroll
          for (int k = 0; k < 4; ++k) { const int ww = part * 4 + k; if (ww < w) sacc += wgcnt[ww * 8 + e]; }
          __hip_atomic_fetch_add(tot + 16 + e, sacc, __ATOMIC_RELAXED, __HIP_MEMORY_SCOPE_WORKGROUP); }
        __syncthreads();
#pragma unroll 1
        for (int k8 = 0; k8 < 8; ++k8) {
            const int m = w * 64 + c.wave * 8 + k8; const int e0 = toke[2 * m], e1 = toke[2 * m + 1];
            unsigned p0 = 0, p1 = 0;
#pragma unroll
            for (int q = 0; q < 8; ++q) { if (q == e0) p0 = pst[q]; if (q == e1) p1 = pst[q]; }
            const int d0 = (int)(p0 + tot[16 + e0]) + tokd[2 * m], d1 = (int)(p1 + tot[16 + e1]) + tokd[2 * m + 1];
            const u32x4* src = (const u32x4*)(H + (size_t)m * DM) + 4 * c.lane;
            const float rr = ((const float*)(ws + WS_MISC + MS_RSTD))[m]; unsigned w8[8];
#pragma unroll
            for (int j = 0; j < 4; ++j) { const u32x4 v = src[j]; w8[2 * j] = pk4_fp8(lo16(v.x) * rr, hi16(v.x) * rr, lo16(v.y) * rr, hi16(v.y) * rr); w8[2 * j + 1] = pk4_fp8(lo16(v.z) * rr, hi16(v.z) * rr, lo16(v.w) * rr, hi16(v.w) * rr); }
            { u32x4* q0 = (u32x4*)(XBM + (size_t)d0 * DM) + 2 * c.lane; u32x4* q1 = (u32x4*)(XBM + (size_t)d1 * DM) + 2 * c.lane; const u32x4 lo = (u32x4){w8[0], w8[1], w8[2], w8[3]}, hi = (u32x4){w8[4], w8[5], w8[6], w8[7]};
              q0[0] = lo; q0[1] = hi; q1[0] = lo; q1[1] = hi; }
            if (c.lane == 0) { tokd[2 * m] = d0; tokd[2 * m + 1] = d1; }
        }
    }
    for (int e = 0; e < 8; ++e) { const unsigned r0 = pst[e] + cnt[e], r1 = pst[e] + ((cnt[e] + 255u) & ~255u);
        for (unsigned r = r0 + c.gw; r < r1; r += c.ngw) {
            ((u32x4*)(XBM + (size_t)r * DM) + 2 * c.lane)[0] = (u32x4){0u, 0u, 0u, 0u}; ((u32x4*)(XBM + (size_t)r * DM) + 2 * c.lane)[1] = (u32x4){0u, 0u, 0u, 0u}; } }
}
__device__ __forceinline__ void ph_combine(KArgs a, const Ctx& c) {
    unsigned char* ws = a.ws; const bf16* YB = (const bf16*)(ws + WS_YB); const bf16* X3 = (const bf16*)(ws + WS_H); const float* tokg = (const float*)(ws + WS_MISC + MS_TOKG); const int* tokd = (const int*)(ws + WS_MISC + MS_TOKD);
    for (int m = c.gw; m < MTOK; m += c.ngw) {
        const int d0 = tokd[2 * m], d1 = tokd[2 * m + 1]; const float g0 = tokg[2 * m], g1 = tokg[2 * m + 1];
        const u32x4* x3 = (const u32x4*)(X3 + (size_t)m * DM) + c.lane; const u32x4* y0 = (const u32x4*)(YB + (size_t)d0 * DM) + c.lane; const u32x4* y1 = (const u32x4*)(YB + (size_t)d1 * DM) + c.lane;
        f32x4* xo = (f32x4*)(a.out + (size_t)m * DM) + c.lane * 2;
        u32x4 pp[4], qq[4], xx[4];
#pragma unroll
        for (int j = 0; j < 4; ++j) { pp[j] = y0[64 * j]; qq[j] = y1[64 * j]; xx[j] = x3[64 * j]; }
#pragma unroll
        for (int j = 0; j < 4; ++j) { const u32x4 p = pp[j], q = qq[j], x = xx[j]; f32x4 xa, xb;
            xa.x = lo16(x.x) + g0 * lo16(p.x) + g1 * lo16(q.x); xa.y = hi16(x.x) + g0 * hi16(p.x) + g1 * hi16(q.x); xa.z = lo16(x.y) + g0 * lo16(p.y) + g1 * lo16(q.y); xa.w = hi16(x.y) + g0 * hi16(p.y) + g1 * hi16(q.y);
            xb.x = lo16(x.z) + g0 * lo16(p.z) + g1 * lo16(q.z); xb.y = hi16(x.z) + g0 * hi16(p.z) + g1 * hi16(q.z); xb.z = lo16(x.w) + g0 * lo16(p.w) + g1 * lo16(q.w); xb.w = hi16(x.w) + g0 * hi16(p.w) + g1 * hi16(q.w);
            xo[128 * j] = xa; xo[128 * j + 1] = xb; }
    }
}


#define XB_TMO      128
#define XB_XCNT(j)  (256  + 64 * (j))
#define XB_XSUB(j)  (1280 + 64 * (j))
#define XB_XGEN(j)  (2304 + 64 * (j))
#define XB_TOP      3328
#define XB_TOPGEN   3392
#define XCD_BAR_WORDS 3456
#define XB_SPIN_CAP (1u << 18)
__device__ __forceinline__ unsigned xb_ld(unsigned* p)              { return __hip_atomic_load(p, __ATOMIC_RELAXED, __HIP_MEMORY_SCOPE_AGENT); }
__device__ __forceinline__ unsigned xb_add(unsigned* p, unsigned v) { return __hip_atomic_fetch_add(p, v, __ATOMIC_RELAXED, __HIP_MEMORY_SCOPE_AGENT); }
__device__ __forceinline__ unsigned xb_xcc_id() { return (unsigned)__builtin_amdgcn_s_getreg((3 << 11) | 20) & 0xFu; }
#define XB_SPIN(cond, bar) do { unsigned _sp = 0; while (cond) { __builtin_amdgcn_s_sleep(1); \
    if ((++_sp & 255u) == 0u) { if (xb_ld(&(bar)[XB_TMO])) break; if (_sp > XB_SPIN_CAP) { atomicAdd(&(bar)[XB_TMO], 1u); break; } } } } while (0)
struct XcdBarrier { unsigned* bar; unsigned x; volatile LAS unsigned* st; };
__device__ __forceinline__ XcdBarrier xcd_barrier_post(unsigned* bar, volatile LAS unsigned* st) {
    XcdBarrier b; b.bar = bar; b.x = xb_xcc_id(); b.st = st;
    if (threadIdx.x == 0) (void)xb_add(&bar[XB_XCNT(b.x)], 1u);
    return b;
}
__device__ __forceinline__ void xcd_barrier_complete(unsigned* bar, unsigned x, unsigned& nloc, unsigned& nx) {
    const unsigned G = gridDim.x * gridDim.y * gridDim.z;
    unsigned sum, cnt, mine, sp = 0u;
    for (;;) {
        sum = 0u; cnt = 0u; mine = 0u;
#pragma unroll
        for (unsigned j = 0; j < 16; ++j) { const unsigned c = xb_ld(&bar[XB_XCNT(j)]); sum += c; cnt += (c > 0u) ? 1u : 0u; mine = (j == x) ? c : mine; }
        if (sum == G) break;
        __builtin_amdgcn_s_sleep(1);
        if ((++sp & 255u) == 0u) { if (xb_ld(&bar[XB_TMO])) break; if (sp > XB_SPIN_CAP) { atomicAdd(&bar[XB_TMO], 1u); break; } }
    }
    nloc = mine > 0u ? mine : 1u; nx = cnt > 0u ? cnt : 1u;
}
__device__ __forceinline__ void xcd_barrier(const XcdBarrier& b) {
    asm volatile("s_waitcnt vmcnt(0)" ::: "memory");
    __syncthreads();
    if (threadIdx.x == 0) {
        unsigned* bar = b.bar;
        __builtin_amdgcn_s_waitcnt(0);
        unsigned nloc = b.st[0], nx = b.st[1];
        if (nloc == 0u) { xcd_barrier_complete(bar, b.x, nloc, nx); b.st[0] = nloc; b.st[1] = nx; }
        const unsigned old = xb_add(&bar[XB_XSUB(b.x)], 1u);
        const unsigned gen = old / nloc;
        if (old + 1u == (gen + 1u) * nloc) {
            __builtin_amdgcn_fence(__ATOMIC_RELEASE, "agent");
            asm volatile("s_waitcnt vmcnt(0)" ::: "memory");
            const unsigned og = xb_add(&bar[XB_TOP], 1u);
            const unsigned tg = og / nx;
            if (og + 1u == (tg + 1u) * nx) xb_add(&bar[XB_TOPGEN], 1u);
            else XB_SPIN(xb_ld(&bar[XB_TOPGEN]) == tg, bar);
            __builtin_amdgcn_fence(__ATOMIC_ACQUIRE, "agent");
            xb_add(&bar[XB_XGEN(b.x)], 1u);
            asm volatile("s_waitcnt vmcnt(0)" ::: "memory");
        } else {
            XB_SPIN(xb_ld(&bar[XB_XGEN(b.x)]) == gen, bar);
            __builtin_amdgcn_fence(__ATOMIC_ACQUIRE, "agent");
            asm volatile("s_waitcnt vmcnt(0)" ::: "memory");
        }
    }
    __syncthreads();
}

enum { P_PRO = 0, P_G1, P_PREP0, P_MLS, P_MIX, P_MLP, P_G2, P_G3, P_G4, P_G5, P_RS, P_RQ, P_RP, P_G6, P_ROUTE, P_DISP, P_G7, P_G8, P_COMB, P_END };

template <int PH> __device__ __forceinline__ void run_phase(LAS unsigned char* lds) {
    KArgs a = get_args(); unsigned char* ws = a.ws; const int G = gridDim.x, bx = blockIdx.x;
#define MK_CTX(cn) Ctx cn; { int t_ = threadIdx.x; asm volatile("" : "+v"(t_)); cn.tid = t_; } cn.lane = cn.tid & 63; cn.wave = __builtin_amdgcn_readfirstlane(cn.tid >> 6); cn.gw = bx * NWAVES + cn.wave; cn.ngw = G * NWAVES
    MK_CTX(c);
    if constexpr (PH == P_PRO) ph_prologue(a, lds, c);
    if constexpr (PH == P_G1) { pg8::Gemm g{(const bf16*)(ws + WS_H), (const bf16*)(ws + WS_WIE), DM, (const float*)(ws + WS_RSS)}; pg8::PanelOrder S; S.init(MTOK / 256, LDY0 / 256, G, bx);
        pg8::EpiBf16RS E{(bf16*)(ws + WS_Y0), LDY0}; pg8::gemm_phase<false>(lds, g, S, E); }
    if constexpr (PH == P_PREP0) { ph_compress(a, lds, c); MK_CTX(c2); ph_vtrans(a, lds, c2); MK_CTX(c3); ph_prep0(a, c3); }
    if constexpr (PH == P_MLS) ph_ml_s(a, lds, c);
    if constexpr (PH == P_MIX) { ph_ml_q(a, lds, c); MK_CTX(c2); ph_nsa(a, lds, c2); }
    if constexpr (PH == P_MLP) ph_mlstm_post(a, c);
    if constexpr (PH == P_G2) { pg8::Gemm g{(const bf16*)(ws + WS_MIXED), (const bf16*)(ws + WS_WOE), DM, nullptr}; pg8::StaticOrder S; S.init(MTOK / 256, DM / 256, G, bx);
        pg8::EpiResB16<true> E{(const bf16*)(ws + WS_H), (bf16*)(ws + WS_XB), DM, (float*)(ws + WS_RSS)}; pg8::gemm_phase<false>(lds, g, S, E); }
    if constexpr (PH == P_G3) { pg8::Gemm g{(const bf16*)(ws + WS_XB), (const bf16*)(ws + WS_WGU), DM, (const float*)(ws + WS_RSS)}; pg8::PanelOrder S; S.init(MTOK / 256, 2 * FFN / 256, G, bx);
        pg8::EpiSwigluRS E{(bf16*)(ws + WS_ACT), FFN}; pg8::gemm_phase<false>(lds, g, S, E); }
    if constexpr (PH == P_G4) { pg8::Gemm g{(const bf16*)(ws + WS_ACT), (const bf16*)(ws + WS_WD), FFN, nullptr}; pg8::StaticOrder S; S.init(MTOK / 256, DM / 256, G, bx);
        pg8::EpiResB16<true> E{(const bf16*)(ws + WS_XB), (bf16*)(ws + WS_XB + 64 * MiB), DM, (float*)(ws + WS_RSS)}; pg8::gemm_phase<false>(lds, g, S, E); }
    if constexpr (PH == P_G5) { pg8::Gemm g{(const bf16*)(ws + WS_XB + 64 * MiB), (const bf16*)(ws + WS_WIO), DM, (const float*)(ws + WS_RSS)}; pg8::PanelOrder S; S.init(MTOK / 256, LDY1 / 256, G, bx);
        pg8::EpiBf16RopeRS E{(bf16*)(ws + WS_Y1), LDY1, (const int*)a.in[I_POS]}; pg8::gemm_phase<false>(lds, g, S, E); }
    if constexpr (PH == P_RS) ph_ret_s(a, lds, c);
    if constexpr (PH == P_RQ) ph_ret_q(a, lds, c);
    if constexpr (PH == P_RP) ph_ret_post(a, c);
    if constexpr (PH == P_G6) { pg8::Gemm g{(const bf16*)(ws + WS_YRET), (const bf16*)(ws + WS_WOO), 2 * DM, nullptr}; pg8::StaticOrder S; S.init(MTOK / 256, DM / 256, G, bx);
        pg8::EpiResB16<false> E{(const bf16*)(ws + WS_XB + 64 * MiB), (bf16*)(ws + WS_H), DM, nullptr}; pg8::gemm_phase<false>(lds, g, S, E); }
    if constexpr (PH == P_ROUTE) ph_route(a, lds, c);
    if constexpr (PH == P_DISP) ph_dispatch(a, lds, c);
    if constexpr (PH == P_G7) { const unsigned* ctl = (const unsigned*)(ws + WS_CTL); const int nblk = (int)__hip_atomic_load(ctl + CW_NBLK, __ATOMIC_RELAXED, __HIP_MEMORY_SCOPE_AGENT);
        pg8::Gemm g{ws + WS_XBM, ws + WS_EGU, DM, nullptr}; pg8::MoeOrder S; S.init(nblk, 2 * FFN / 256, G, bx); S.load(ctl + CW_PST); S.estride = (size_t)2 * FFN * DM;
        pg8::EpiSwigluF8 E{ws + WS_ACTE, FFN, 1.f / 64.f, 4.f}; pg8::gemm_phase<true>(lds, g, S, E); }
    if constexpr (PH == P_G8) { const unsigned* ctl = (const unsigned*)(ws + WS_CTL); const int nblk = (int)__hip_atomic_load(ctl + CW_NBLK, __ATOMIC_RELAXED, __HIP_MEMORY_SCOPE_AGENT);
        pg8::Gemm g{ws + WS_ACTE, ws + WS_ED, FFN, nullptr}; pg8::MoeOrder S; S.init(nblk, DM / 256, G, bx); S.load(ctl + CW_PST); S.estride = (size_t)FFN * DM;
        pg8::EpiBf16 E{(bf16*)(ws + WS_YB), DM, 1.f / 256.f}; pg8::gemm_phase<true>(lds, g, S, E); }
    if constexpr (PH == P_COMB) ph_combine(a, c);
}

template <int PH> __global__ void __launch_bounds__(NTHR, 2) k_phase(Args a) {
    extern __shared__ __attribute__((aligned(16))) unsigned char lds_raw[];
    LAS unsigned char* lds = (LAS unsigned char*)lds_raw;
    run_phase<PH>(lds);
}

template <int PH> __device__ __forceinline__ void run_from(LAS unsigned char* lds, const XcdBarrier& bar) {
    if constexpr (PH < P_END) {
        run_phase<PH>(lds);
#if defined(PROBE_DUP)
        if constexpr (((PROBE_DUP) >> PH) & 1ull) { xcd_barrier(bar); run_phase<PH>(lds); }
#endif
        if constexpr (PH + 1 < P_END) xcd_barrier(bar);
        run_from<PH + 1>(lds, bar);
    }
}
__global__ void __launch_bounds__(NTHR, 2) k_all(Args a) {
    extern __shared__ __attribute__((aligned(16))) unsigned char lds_raw[];
    LAS unsigned char* lds = (LAS unsigned char*)lds_raw;
    volatile LAS unsigned* misc = (volatile LAS unsigned*)(lds + MISC_OFF);
    if (threadIdx.x < 4) misc[threadIdx.x] = 0u;
    __syncthreads();
    const XcdBarrier bar = xcd_barrier_post((unsigned*)(get_args().ws + WS_CTL) + CW_BAR, misc);
    run_from<0>(lds, bar);
}

template <int PH> static void launch_phase(const Args& a, int grid, hipStream_t stream) {
    static bool attr = false;
    if (!attr) { (void)hipFuncSetAttribute((const void*)k_phase<PH>, hipFuncAttributeMaxDynamicSharedMemorySize, LDS_BYTES); attr = true; }
    hipLaunchKernelGGL(k_phase<PH>, dim3(grid), dim3(NTHR), LDS_BYTES, stream, a);
}
template <int PH> static void launch_all(const Args& a, int grid, hipStream_t stream) {
    if constexpr (PH < P_END) { launch_phase<PH>(a, grid, stream); launch_all<PH + 1>(a, grid, stream); }
}

extern "C" void kernel_launch(void* const* d_in, const int* in_sizes, int n_in, void* d_out, int out_size, void* d_ws, size_t ws_size, hipStream_t stream) {
    if (n_in != 26 || ws_size < WS_NEED) { fprintf(stderr, "kernel_launch: unexpected inputs (n_in %d, ws %zu, need %zu)\n", n_in, ws_size, (size_t)WS_NEED); return; }
    (void)hipMemsetAsync((char*)d_ws + WS_CTL, 0, CTL_ZERO_BYTES, stream);
    Args a{};
    for (int i = 0; i < 26; ++i) a.in[i] = (const float*)d_in[i];
    a.out = (float*)d_out; a.ws = (unsigned char*)d_ws; a.ph_lo = 0; a.ph_hi = P_END;
#if defined(MK_MULTI)
    launch_all<0>(a, 256, stream);
#else
    static bool attr = false;
    if (!attr) { (void)hipFuncSetAttribute((const void*)k_all, hipFuncAttributeMaxDynamicSharedMemorySize, LDS_BYTES); attr = true; }
    hipLaunchKernelGGL(k_all, dim3(256), dim3(NTHR), LDS_BYTES, stream, a);
#endif
}
```
